# Optimizing an MI355X kernel written in HIP

```python
import math
import numpy as np
import jax
import jax.numpy as jnp
from jax import lax

D_MODEL = 2048
BATCH = 16
SEQ = 2048
DEPTH = 1

SSD_D_INNER = D_MODEL
SSD_HEAD_DIM = 64
SSD_HEADS = SSD_D_INNER // SSD_HEAD_DIM
SSD_GROUPS = 4
SSD_D_STATE = 128
SSD_CONV_K = 4
SSD_CHUNK = 128
SSD_CONV_DIM = SSD_D_INNER + 2 * SSD_GROUPS * SSD_D_STATE

NSA_HEADS = 16
NSA_HEAD_DIM = 128
NSA_KV_GROUPS = 2
NSA_HPG = NSA_HEADS // NSA_KV_GROUPS
NSA_D = NSA_HEADS * NSA_HEAD_DIM
NSA_KV_D = NSA_KV_GROUPS * NSA_HEAD_DIM
N_NSA_BRANCHES = 3
CMP_BLOCK = 32
CMP_STRIDE = 16
SEL_BLOCK = 64
SEL_TOPK = 8
WINDOW = 512
Q_BLOCK = 128

IN_DIM = (SSD_D_INNER + SSD_CONV_DIM + SSD_HEADS
          + NSA_D + 6 * NSA_KV_D + NSA_D + NSA_HEADS * N_NSA_BRANCHES
          + 2 * D_MODEL)
EPS = 1e-6
NEG_INF = -1e30
FORCED_SCORE = 1e9

kernel_name = 'hybrid_ssd_nsa_gated_block'


def rms_norm(x, w):
    xf = x.astype(jnp.float32)
    xf = xf * lax.rsqrt(jnp.mean(xf * xf, axis=-1, keepdims=True) + EPS)
    return (xf * w.astype(jnp.float32)).astype(x.dtype)


def masked_softmax(s, mask):
    s = jnp.where(mask, s.astype(jnp.float32), NEG_INF)
    return jnp.where(mask, jax.nn.softmax(s, axis=-1), 0.0)


def causal_dwconv(u, w, b):
    k, c = w.shape
    y = lax.conv_general_dilated(u, w[:, None, :].astype(u.dtype), window_strides=(1,),
                                 padding=[(k - 1, 0)], dimension_numbers=('NWC', 'WIO', 'NWC'),
                                 feature_group_count=c)
    return y + b.astype(u.dtype)


def ssd_chunked(x, dt, a, bmat, cmat):
    b_, t_, h_, p_ = x.shape
    g_, n_ = bmat.shape[2], bmat.shape[3]
    hpg = h_ // g_
    q_ = SSD_CHUNK
    nc = t_ // q_
    xc = (x * dt[..., None].astype(x.dtype)).reshape(b_, nc, q_, g_, hpg, p_)
    bc = bmat.reshape(b_, nc, q_, g_, n_)
    cc = cmat.reshape(b_, nc, q_, g_, n_)
    la = (dt * a).reshape(b_, nc, q_, g_, hpg).transpose(0, 1, 3, 4, 2)
    la_cum = jnp.cumsum(la, axis=-1)
    causal = jnp.tril(jnp.ones((q_, q_), bool))
    seg = la_cum[..., :, None] - la_cum[..., None, :]
    lmat = jnp.exp(jnp.where(causal, seg, -jnp.inf)).astype(x.dtype)
    cb = jnp.einsum('bclgn,bcsgn->bcgls', cc, bc)
    y_diag = jnp.einsum('bcgls,bcgkls,bcsgkp->bclgkp', cb, lmat, xc)
    decay_to_end = jnp.exp(la_cum[..., -1:] - la_cum).astype(x.dtype)
    states = jnp.einsum('bcsgn,bcgks,bcsgkp->bcgkpn', bc, decay_to_end, xc)
    chunk_decay = jnp.exp(la_cum[..., -1])

    def step(h, inp):
        st, dec = inp
        return h * dec[..., None, None] + st.astype(jnp.float32), h

    h0 = jnp.zeros((b_, g_, hpg, p_, n_), jnp.float32)
    _, prev = lax.scan(step, h0, (jnp.moveaxis(states, 1, 0), jnp.moveaxis(chunk_decay, 1, 0)))
    prev = jnp.moveaxis(prev, 0, 1).astype(x.dtype)
    decay_from_start = jnp.exp(la_cum).astype(x.dtype)
    y_off = jnp.einsum('bclgn,bcgkpn,bcgkl->bclgkp', cc, prev, decay_from_start)
    return (y_diag + y_off).reshape(b_, t_, h_, p_)


def ssd_branch(z, xbc, dt_raw, conv_w, conv_b, dt_bias, a_log, d_skip, ssd_norm_w, w_out):
    b, t, _ = xbc.shape
    xbc = jax.nn.silu(causal_dwconv(xbc, conv_w, conv_b))
    xs, bs, cs = jnp.split(xbc, [SSD_D_INNER, SSD_D_INNER + SSD_GROUPS * SSD_D_STATE], axis=-1)
    xs = xs.reshape(b, t, SSD_HEADS, SSD_HEAD_DIM)
    dt = jax.nn.softplus(dt_raw.astype(jnp.float32) + dt_bias.astype(jnp.float32))
    a = -jnp.exp(a_log.astype(jnp.float32))
    y = ssd_chunked(xs, dt, a, bs.reshape(b, t, SSD_GROUPS, SSD_D_STATE),
                    cs.reshape(b, t, SSD_GROUPS, SSD_D_STATE))
    y = y + xs * d_skip[:, None].astype(xs.dtype)
    y = rms_norm(y.reshape(b, t, SSD_D_INNER) * jax.nn.silu(z), ssd_norm_w)
    return y @ w_out


def compress_blocks(kv, pe, w1, b1, w2):
    b, t, g, d = kv.shape
    n_cmp = (t - CMP_BLOCK) // CMP_STRIDE + 1
    idx = np.arange(n_cmp)[:, None] * CMP_STRIDE + np.arange(CMP_BLOCK)[None, :]
    blk = kv[:, idx] + pe[None, None, :, None, :]
    blk = blk.transpose(0, 1, 3, 2, 4).reshape(b, n_cmp, g, CMP_BLOCK * d)
    return jax.nn.silu(blk @ w1 + b1) @ w2


def nsa_branch(q, k_cmp, v_cmp, k_slc, v_slc, k_win, v_win, z, gate_logits,
               q_norm_w, k_cmp_norm_w, k_slc_norm_w, k_win_norm_w,
               cmp_pe_k, cmp_w1_k, cmp_b1_k, cmp_w2_k,
               cmp_pe_v, cmp_w1_v, cmp_b1_v, cmp_w2_v, w_out):
    b, t, _ = q.shape
    dtype = q.dtype
    G, K, HD = NSA_KV_GROUPS, NSA_HPG, NSA_HEAD_DIM
    scale = HD ** -0.5
    q = rms_norm(q.reshape(b, t, NSA_HEADS, HD), q_norm_w).reshape(b, t, G, K, HD)
    kv_shape = (b, t, G, HD)
    k_slc = rms_norm(k_slc.reshape(kv_shape), k_slc_norm_w)
    k_win = rms_norm(k_win.reshape(kv_shape), k_win_norm_w)
    v_slc = v_slc.reshape(kv_shape)
    v_win = v_win.reshape(kv_shape)
    kc = rms_norm(compress_blocks(k_cmp.reshape(kv_shape), cmp_pe_k, cmp_w1_k, cmp_b1_k, cmp_w2_k), k_cmp_norm_w)
    vc = compress_blocks(v_cmp.reshape(kv_shape), cmp_pe_v, cmp_w1_v, cmp_b1_v, cmp_w2_v)
    n_cmp = kc.shape[1]
    cmp_end = jnp.asarray(np.arange(n_cmp) * CMP_STRIDE + CMP_BLOCK - 1, jnp.int32)
    n_slc = t // SEL_BLOCK
    n_sel = min(SEL_TOPK, n_slc)
    ci = np.arange(n_cmp)[:, None] * CMP_STRIDE
    sj = np.arange(n_slc)[None, :] * SEL_BLOCK
    sel_map = jnp.asarray(((ci < sj + SEL_BLOCK) & (ci + CMP_BLOCK > sj)).astype(np.float32))
    ks_blocks = k_slc.reshape(b, n_slc, SEL_BLOCK, G, HD).transpose(0, 3, 1, 2, 4)
    vs_blocks = v_slc.reshape(b, n_slc, SEL_BLOCK, G, HD).transpose(0, 3, 1, 2, 4)
    blk_idx = jnp.arange(n_slc)
    b_idx = jnp.arange(b)[:, None, None, None]
    g_idx = jnp.arange(G)[None, :, None, None]
    pad = ((0, 0), (WINDOW, 0), (0, 0), (0, 0))
    k_win_p = jnp.pad(k_win, pad)
    v_win_p = jnp.pad(v_win, pad)
    gates = jax.nn.sigmoid(gate_logits.astype(jnp.float32)).astype(dtype).reshape(b, t, G, K, N_NSA_BRANCHES)

    def query_block(i):
        qs = i * Q_BLOCK
        tq = qs + jnp.arange(Q_BLOCK)
        qb = lax.dynamic_slice_in_dim(q, qs, Q_BLOCK, axis=1)
        s = jnp.einsum('bqgkd,bcgd->bgkqc', qb, kc) * scale
        p_cmp = masked_softmax(s, cmp_end[None, :] <= tq[:, None])
        o_cmp = jnp.einsum('bgkqc,bcgd->bqgkd', p_cmp.astype(dtype), vc)
        imp = jnp.einsum('bgkqc,cj->bgqj', p_cmp, sel_map)
        blk_valid = blk_idx[None, :] * SEL_BLOCK <= tq[:, None]
        forced = (blk_idx[None, :] == (tq // SEL_BLOCK)[:, None]) | (blk_idx[None, :] == 0)
        imp = jnp.where(forced, FORCED_SCORE, jnp.where(blk_valid, imp, -1.0))
        _, sel = lax.top_k(imp, n_sel)
        kg = ks_blocks[b_idx, g_idx, sel]
        vg = vs_blocks[b_idx, g_idx, sel]
        pos = sel[..., None] * SEL_BLOCK + jnp.arange(SEL_BLOCK)
        mask_s = (pos <= tq[None, None, :, None, None]).reshape(b, G, 1, Q_BLOCK, n_sel * SEL_BLOCK)
        s = jnp.einsum('bqgkd,bgqnld->bgkqnl', qb, kg).reshape(b, G, K, Q_BLOCK, n_sel * SEL_BLOCK) * scale
        p = masked_softmax(s, mask_s).astype(dtype).reshape(b, G, K, Q_BLOCK, n_sel, SEL_BLOCK)
        o_slc = jnp.einsum('bgkqnl,bgqnld->bqgkd', p, vg)
        kw = lax.dynamic_slice_in_dim(k_win_p, qs, Q_BLOCK + WINDOW, axis=1)
        vw = lax.dynamic_slice_in_dim(v_win_p, qs, Q_BLOCK + WINDOW, axis=1)
        kpos = qs - WINDOW + jnp.arange(Q_BLOCK + WINDOW)
        mask_w = ((kpos[None, :] <= tq[:, None]) & (kpos[None, :] > tq[:, None] - WINDOW)
                  & (kpos[None, :] >= 0))
        s = jnp.einsum('bqgkd,bsgd->bgkqs', qb, kw) * scale
        p = masked_softmax(s, mask_w).astype(dtype)
        o_win = jnp.einsum('bgkqs,bsgd->bqgkd', p, vw)
        gb = lax.dynamic_slice_in_dim(gates, qs, Q_BLOCK, axis=1)
        o = gb[..., 0:1] * o_cmp + gb[..., 1:2] * o_slc + gb[..., 2:3] * o_win
        return o.reshape(b, Q_BLOCK, NSA_D)

    out = lax.map(query_block, jnp.arange(t // Q_BLOCK))
    out = jnp.moveaxis(out, 0, 1).reshape(b, t, NSA_D)
    return (out * jax.nn.silu(z)) @ w_out


def setup_inputs(seed: int = 0) -> dict:
    key = jax.random.key(seed)
    ks = jax.random.split(key, 24)
    f32 = jnp.float32
    hd = NSA_HEAD_DIM

    def nrm(k, shape, scale):
        return jax.random.normal(k, shape, f32) * scale

    def gain(k, n):
        return 1.0 + 0.05 * jax.random.normal(k, (n,), f32)

    dt0 = jnp.exp(jax.random.uniform(ks[5], (SSD_HEADS,), f32) * (math.log(0.1) - math.log(0.001))
                  + math.log(0.001))
    dt_bias = dt0 + jnp.log(-jnp.expm1(-dt0))
    return {
        'x': nrm(ks[0], (BATCH, SEQ, D_MODEL), 1.0),
        'norm_w': gain(ks[1], D_MODEL),
        'w_in': nrm(ks[2], (D_MODEL, IN_DIM), D_MODEL ** -0.5),
        'conv_w': nrm(ks[3], (SSD_CONV_K, SSD_CONV_DIM), SSD_CONV_K ** -0.5),
        'conv_b': nrm(ks[4], (SSD_CONV_DIM,), 0.01),
        'dt_bias': dt_bias,
        'a_log': jnp.log(jax.random.uniform(ks[6], (SSD_HEADS,), f32, 1.0, 16.0)),
        'd_skip': gain(ks[7], SSD_HEADS),
        'ssd_norm_w': gain(ks[8], SSD_D_INNER),
        'q_norm_w': gain(ks[9], hd),
        'k_cmp_norm_w': gain(ks[10], hd),
        'k_slc_norm_w': gain(ks[11], hd),
        'k_win_norm_w': gain(ks[12], hd),
        'cmp_pe_k': nrm(ks[13], (CMP_BLOCK, hd), 0.02),
        'cmp_w1_k': nrm(ks[14], (CMP_BLOCK * hd, hd), (CMP_BLOCK * hd) ** -0.5),
        'cmp_b1_k': nrm(ks[15], (hd,), 0.01),
        'cmp_w2_k': nrm(ks[16], (hd, hd), hd ** -0.5),
        'cmp_pe_v': nrm(ks[17], (CMP_BLOCK, hd), 0.02),
        'cmp_w1_v': nrm(ks[18], (CMP_BLOCK * hd, hd), (CMP_BLOCK * hd) ** -0.5),
        'cmp_b1_v': nrm(ks[19], (hd,), 0.01),
        'cmp_w2_v': nrm(ks[20], (hd, hd), hd ** -0.5),
        'w_out_ssd': nrm(ks[21], (SSD_D_INNER, D_MODEL), SSD_D_INNER ** -0.5),
        'w_out_nsa': nrm(ks[22], (NSA_D, D_MODEL), NSA_D ** -0.5),
        'w_o': nrm(ks[23], (D_MODEL, D_MODEL), D_MODEL ** -0.5),
    }


def reference(x, norm_w, w_in, conv_w, conv_b, dt_bias, a_log, d_skip, ssd_norm_w,
              q_norm_w, k_cmp_norm_w, k_slc_norm_w, k_win_norm_w,
              cmp_pe_k, cmp_w1_k, cmp_b1_k, cmp_w2_k,
              cmp_pe_v, cmp_w1_v, cmp_b1_v, cmp_w2_v,
              w_out_ssd, w_out_nsa, w_o):
    sizes = [SSD_D_INNER, SSD_CONV_DIM, SSD_HEADS,
             NSA_D, NSA_KV_D, NSA_KV_D, NSA_KV_D, NSA_KV_D, NSA_KV_D, NSA_KV_D,
             NSA_D, NSA_HEADS * N_NSA_BRANCHES, D_MODEL, D_MODEL]
    offs = [int(o) for o in np.cumsum(sizes)[:-1]]
    for _ in range(DEPTH):
        h = rms_norm(x, norm_w)
        proj = h @ w_in
        (z_ssd, xbc, dt_raw, q, k_cmp, v_cmp, k_slc, v_slc, k_win, v_win,
         z_nsa, nsa_gate_logits, gl_ssd, gl_nsa) = jnp.split(proj, offs, axis=-1)
        y_ssd = ssd_branch(z_ssd, xbc, dt_raw, conv_w, conv_b, dt_bias, a_log, d_skip,
                           ssd_norm_w, w_out_ssd)
        y_nsa = nsa_branch(q, k_cmp, v_cmp, k_slc, v_slc, k_win, v_win, z_nsa, nsa_gate_logits,
                           q_norm_w, k_cmp_norm_w, k_slc_norm_w, k_win_norm_w,
                           cmp_pe_k, cmp_w1_k, cmp_b1_k, cmp_w2_k,
                           cmp_pe_v, cmp_w1_v, cmp_b1_v, cmp_w2_v, w_out_nsa)
        merged = jax.nn.sigmoid(gl_ssd) * y_ssd + jax.nn.sigmoid(gl_nsa) * y_nsa
        x = x + merged @ w_o
    return x
```

```cpp
#include <hip/hip_runtime.h>
#include <hip/hip_cooperative_groups.h>
#include <cstdio>
namespace cg = cooperative_groups;

#ifndef PROBE_DUP
#define PROBE_DUP -1
#endif
#ifndef ONE_LAUNCH
#define ONE_LAUNCH 1
#endif

#define DI __device__ __forceinline__
#define LAS __attribute__((address_space(3)))
typedef unsigned short bf16_t;
typedef short bf16x8 __attribute__((ext_vector_type(8)));
typedef short s16x4 __attribute__((ext_vector_type(4)));
typedef float f32x4 __attribute__((ext_vector_type(4)));
typedef float f32x2 __attribute__((ext_vector_type(2)));
typedef float f32x16 __attribute__((ext_vector_type(16)));
typedef unsigned u32x4 __attribute__((ext_vector_type(4)));
typedef unsigned u32x2 __attribute__((ext_vector_type(2)));
typedef __bf16 bf16x2_t __attribute__((ext_vector_type(2)));

constexpr int NTOK = 32768, TT = 2048, DM = 2048, LDP = 15104, INDIM = 14928;
constexpr int C_Z = 0, C_X = 2048, C_BM = 4096, C_CM = 4608, C_Q = 5120, C_KCMP = 7168, C_VCMP = 7424, C_KSLC = 7680, C_VSLC = 7936,
              C_KWIN = 8192, C_VWIN = 8448, C_ZNSA = 8704, C_GLS = 10752, C_GLN = 12800, C_DT = 14848, C_GATE = 14880;
constexpr float EPSF = 1e-6f;
constexpr int LDS_BYTES = 160 * 1024;

constexpr size_t WS_PROJ = 0, SZ_PROJ = (size_t)NTOK * LDP * 2;
constexpr size_t WS_WINT = WS_PROJ + SZ_PROJ, SZ_WINT = (size_t)LDP * DM * 2;
constexpr size_t WS_WOSSD = WS_WINT, WS_WONSA = WS_WINT + 8388608, WS_WO = WS_WINT + 16777216, WS_VSLCT = WS_WINT + 25165824, WS_VWINT = WS_WINT + 41943040;
constexpr size_t WS_SPARE = WS_WINT + SZ_WINT;
constexpr size_t WS_W1KT = WS_SPARE, WS_W1VT = WS_SPARE + 1048576, WS_W2KT = WS_SPARE + 2097152, WS_W2VT = WS_SPARE + 2129920,
                 WS_BIASK = WS_SPARE + 2162688, WS_BIASV = WS_SPARE + 2166784, WS_KC = WS_SPARE + 2170880, WS_VCT = WS_SPARE + 3219456,
                 WS_PART = WS_SPARE + 4268032, WS_RSTD = WS_SPARE + 12656640, WS_BAR = WS_SPARE + 12787712, WS_END = WS_BAR + 16384;

struct ParamsK {
    const float *x, *norm_w, *w_in, *conv_w, *conv_b, *dt_bias, *a_log, *d_skip, *ssd_norm_w, *q_norm_w, *k_cmp_norm_w, *k_slc_norm_w, *k_win_norm_w,
        *cmp_pe_k, *cmp_w1_k, *cmp_b1_k, *cmp_w2_k, *cmp_pe_v, *cmp_w1_v, *cmp_b1_v, *cmp_w2_v, *w_out_ssd, *w_out_nsa, *w_o;
    float* out; unsigned char* ws;
};
#define WSP(T, off) ((T*)(P.ws + (off)))
#define P_proj   WSP(bf16_t, WS_PROJ)
#define P_winT   WSP(bf16_t, WS_WINT)
#define P_h      ((bf16_t*)P.out)
#define P_yg     ((bf16_t*)P.out)
#define P_onsa   ((bf16_t*)P.out)
#define P_wossdT WSP(bf16_t, WS_WOSSD)
#define P_wonsaT WSP(bf16_t, WS_WONSA)
#define P_woT    WSP(bf16_t, WS_WO)
#define P_vslcT  WSP(bf16_t, WS_VSLCT)
#define P_vwinT  WSP(bf16_t, WS_VWINT)
#define P_kc     WSP(bf16_t, WS_KC)
#define P_vcT    WSP(bf16_t, WS_VCT)
#define P_w1kT   WSP(bf16_t, WS_W1KT)
#define P_w1vT   WSP(bf16_t, WS_W1VT)
#define P_w2kT   WSP(bf16_t, WS_W2KT)
#define P_w2vT   WSP(bf16_t, WS_W2VT)
#define P_biask  WSP(float, WS_BIASK)
#define P_biasv  WSP(float, WS_BIASV)
#define P_part   WSP(float, WS_PART)
#define P_rstd   WSP(float, WS_RSTD)
typedef ParamsK Params;

DI float bf2f(bf16_t u) { return __uint_as_float(((unsigned)u) << 16); }
DI unsigned pk2(float lo, float hi) { f32x2 v = {lo, hi}; bf16x2_t b = __builtin_convertvector(v, bf16x2_t); return __builtin_bit_cast(unsigned, b); }
DI bf16_t f2bf(float f) { return (bf16_t)(pk2(f, 0.f) & 0xffffu); }
DI float lo16(unsigned u) { return __uint_as_float(u << 16); }
DI float hi16(unsigned u) { return __uint_as_float(u & 0xffff0000u); }
DI float sigmoidf_(float x) { return __builtin_amdgcn_rcpf(1.f + __expf(-x)); }
DI float siluf_(float x) { return x * __builtin_amdgcn_rcpf(1.f + __expf(-x)); }
DI float wave_sum(float v) {
#pragma unroll
    for (int o = 1; o < 64; o <<= 1) v += __shfl_xor(v, o);
    return v;
}
DI int opaque_tid() { int t = threadIdx.x; asm volatile("" : "+v"(t)); return t; }
DI int opaque_i(int v) { asm volatile("" : "+v"(v)); return v; }
DI float xh_max(float x) { const unsigned u = __float_as_uint(x); const auto r = __builtin_amdgcn_permlane32_swap(u, u, false, false); return fmaxf(__uint_as_float(r[0]), __uint_as_float(r[1])); }
DI float xh_sum(float x) { const unsigned u = __float_as_uint(x); const auto r = __builtin_amdgcn_permlane32_swap(u, u, false, false); return __uint_as_float(r[0]) + __uint_as_float(r[1]); }
DI int crow(int i, int h) { return (i & 3) + 8 * (i >> 2) + 4 * h; }
#define MFMA32(a, b, c) __builtin_amdgcn_mfma_f32_32x32x16_bf16((a), (b), (c), 0, 0, 0)
DI bf16x8 pack8(const f32x16& x, int s) {
    u32x4 p;
    p.x = pk2(x[8 * s + 0], x[8 * s + 1]); p.y = pk2(x[8 * s + 2], x[8 * s + 3]); p.z = pk2(x[8 * s + 4], x[8 * s + 5]); p.w = pk2(x[8 * s + 6], x[8 * s + 7]);
    return __builtin_bit_cast(bf16x8, p);
}
DI bf16x8 cat44(s16x4 a, s16x4 b) { return __builtin_shufflevector(a, b, 0, 1, 2, 3, 4, 5, 6, 7); }
#define LDS_FENCE() asm volatile("s_waitcnt lgkmcnt(0)" ::: "memory")
#define LDS_BAR() do { asm volatile("s_waitcnt lgkmcnt(0)" ::: "memory"); __builtin_amdgcn_s_barrier(); asm volatile("" ::: "memory"); } while (0)

namespace pg8 {
constexpr int BM = 256, BK = 64, HALF = 128, HTB = HALF * BK * 2, STAGE_BYTES = 8 * HTB, NXCD = 8, WGM = 8;
DI int lds_byte(int r, int c) { const int st = (r >> 4) * 2 + (c >> 5), rr = r & 15, cc = c & 31, ob = rr * 64 + cc * 2; return st * 1024 + (ob ^ (((ob >> 9) & 1) << 5)); }
DI void stage_rc(int b, int& R, int& C) { const int st = b / 1024, sb = b % 1024, swz = sb ^ (((sb >> 9) & 1) << 5); R = (st >> 1) * 16 + swz / 64; C = (st & 1) * 32 + (swz % 64) / 2; }
DI int perm32(int rho) { const int n = rho >> 4, i = rho & 15; return 8 * (i >> 2) + 4 * n + (i & 3); }
struct Unit { int pm, pn; };
struct Gemm { const bf16_t* A; const bf16_t* Bt; int M, N, K, lda, ldb; };
struct StaticOrder {
    int nM, nN, nwg, G, c;
    DI void init(int M, int N, int G_, int c_) { nM = M / BM; nN = N / BM; nwg = nM * nN; G = G_; c = c_; }
    DI bool next(int i, Unit& u) const {
        const long L = (long)i * G + c; if (L >= nwg) return false;
        int wgid = (int)L; { const int q = nwg / NXCD, r = nwg % NXCD, xcd = wgid % NXCD, off = wgid / NXCD; wgid = (xcd < r ? xcd * (q + 1) : r * (q + 1) + (xcd - r) * q) + off; }
        const int nig = WGM * nN, gid = wgid / nig, fm = gid * WGM, gsz = (nM - fm) < WGM ? (nM - fm) : WGM;
        u.pm = fm + ((wgid % nig) % gsz); u.pn = (wgid % nig) / gsz; return true;
    }
};

template <class Epi>
DI void gemm_phase(LAS unsigned char* lds, const Gemm g, const StaticOrder& S, const Epi& E) {
    const int tid = opaque_tid(), wid = __builtin_amdgcn_readfirstlane(tid >> 6), lane = tid & 63, wr = wid >> 2, wc = wid & 3, fr = lane & 15, fq = lane >> 4;
    const int K = g.K, nt = K / BK;
    unsigned voffA[2], voffB[2];
#pragma unroll
    for (int i = 0; i < 2; ++i) { int R, C; stage_rc(tid * 16 + i * 8192, R, C); const int Rb = Epi::PERM ? ((R & ~31) + perm32(R & 31)) : R;
        voffA[i] = (unsigned)(R * g.lda + C) * 2u; voffB[i] = (unsigned)(Rb * g.ldb + C) * 2u; }
    const size_t kstep = (size_t)(BK * 2);
    const size_t hstepA = (size_t)HALF * g.lda * 2, hstepB = (size_t)HALF * g.ldb * 2;
    const size_t tstepA = 2 * hstepA, tstepB = 2 * hstepB;
    const unsigned ldsw = (unsigned)wid * 1024u;
    const int aoff = lds_byte(wr * 64 + fr, fq * 8), boff = lds_byte(wc * 32 + fr, fq * 8);
#define PG8_SA(b, h) (((b) * 2 + (h)) * HTB)
#define PG8_SB(b, h) ((4 + (b) * 2 + (h)) * HTB)
#define PG8_STAGE(bufoff, gbase, voff) do { _Pragma("unroll") for (int _i = 0; _i < 2; ++_i) \
        __builtin_amdgcn_global_load_lds((const unsigned*)((const char*)(gbase) + (voff)[_i]), (LAS unsigned*)(lds + (bufoff) + ldsw + _i * 8192), 16, 0, 0); } while (0)
#define PG8_LDA(dst, b, h) do { _Pragma("unroll") for (int m = 0; m < 4; ++m) _Pragma("unroll") for (int k = 0; k < 2; ++k) dst[m][k] = *(const LAS bf16x8*)(lds + PG8_SA(b, h) + aoff + m * 2048 + k * 1024); } while (0)
#define PG8_LDB(dst, b, h) do { _Pragma("unroll") for (int n = 0; n < 2; ++n) _Pragma("unroll") for (int k = 0; k < 2; ++k) dst[n][k] = *(const LAS bf16x8*)(lds + PG8_SB(b, h) + boff + n * 2048 + k * 1024); } while (0)
#define PG8_MMA(ai, bj, At, Bt) do { __builtin_amdgcn_s_setprio(1); _Pragma("unroll") for (int m = 0; m < 4; ++m) _Pragma("unroll") for (int n = 0; n < 2; ++n) _Pragma("unroll") for (int k = 0; k < 2; ++k) \
        acc[ai][bj][m][n] = __builtin_amdgcn_mfma_f32_16x16x32_bf16(Bt[n][k], At[m][k], acc[ai][bj][m][n], 0, 0, 0); __builtin_amdgcn_s_setprio(0); } while (0)
#define PG8_WAIT_V(n) asm volatile("s_waitcnt vmcnt(" #n ")" ::: "memory")
#define PG8_WAIT_L(n) asm volatile("s_waitcnt lgkmcnt(" #n ")" ::: "memory")
#define PG8_BAR __builtin_amdgcn_s_barrier()
#define PG8_SCHED __builtin_amdgcn_sched_barrier(0)
    Unit cur, nxt; int ui = 0;
    if (!S.next(0, cur)) return;
    f32x4 acc[2][2][4][2];
#pragma unroll
    for (int a = 0; a < 2; ++a)
#pragma unroll
        for (int b = 0; b < 2; ++b)
#pragma unroll
            for (int m = 0; m < 4; ++m)
#pragma unroll
                for (int n = 0; n < 2; ++n) acc[a][b][m][n] = (f32x4){0.f, 0.f, 0.f, 0.f};
    bf16x8 At[4][2], B0[2][2], B1[2][2];
    const char* cA = (const char*)g.A + (size_t)cur.pm * tstepA; const char* cB = (const char*)g.Bt + (size_t)cur.pn * tstepB;
    PG8_STAGE(PG8_SB(0, 0), cB, voffB); PG8_STAGE(PG8_SA(0, 0), cA, voffA); PG8_STAGE(PG8_SB(0, 1), cB + hstepB, voffB); PG8_STAGE(PG8_SA(0, 1), cA + hstepA, voffA);
    if (wr == 1) PG8_BAR;
    PG8_WAIT_V(4); PG8_BAR;
    PG8_STAGE(PG8_SB(1, 0), cB + kstep, voffB); PG8_STAGE(PG8_SA(1, 0), cA + kstep, voffA); PG8_STAGE(PG8_SB(1, 1), cB + hstepB + kstep, voffB);
    PG8_WAIT_V(6); PG8_BAR;
    for (;;) {
        const bool has_next = S.next(ui + 1, nxt);
        const char* nA = has_next ? (const char*)g.A + (size_t)nxt.pm * tstepA : cA; const char* nB = has_next ? (const char*)g.Bt + (size_t)nxt.pn * tstepB : cB;
        for (int t = 0; t < nt; t += 2) {
            const bool last = (t == nt - 2);
            const char* a1 = cA + (size_t)(t + 1) * kstep;
            const char* a2 = last ? nA : cA + (size_t)(t + 2) * kstep; const char* b2 = last ? nB : cB + (size_t)(t + 2) * kstep;
            const char* a3 = a2 + kstep; const char* b3 = b2 + kstep;
            if constexpr (Epi::HAS_MID) { if (t == Epi::MID_T) E.mid(acc, cur, wr, wc, fr, fq); }
            PG8_LDB(B0, 0, 0); PG8_SCHED; PG8_LDA(At, 0, 0); PG8_STAGE(PG8_SA(1, 1), a1 + hstepA, voffA);
            PG8_WAIT_L(8); PG8_BAR; PG8_WAIT_L(0); PG8_MMA(0, 0, At, B0); PG8_BAR; PG8_SCHED;
            PG8_LDB(B1, 0, 1); PG8_STAGE(PG8_SB(0, 0), b2, voffB);
            PG8_BAR; PG8_WAIT_L(0); PG8_MMA(0, 1, At, B1); PG8_BAR;
            PG8_LDA(At, 0, 1); PG8_STAGE(PG8_SA(0, 0), a2, voffA);
            PG8_BAR; PG8_WAIT_L(0); PG8_MMA(1, 0, At, B0); PG8_BAR; PG8_SCHED;
            PG8_STAGE(PG8_SB(0, 1), b2 + hstepB, voffB);
            PG8_WAIT_V(6); PG8_BAR; PG8_MMA(1, 1, At, B1); PG8_BAR;
            PG8_LDB(B0, 1, 0); PG8_SCHED; PG8_LDA(At, 1, 0); PG8_STAGE(PG8_SA(0, 1), a2 + hstepA, voffA);
            PG8_WAIT_L(8); PG8_BAR; PG8_WAIT_L(0); PG8_MMA(0, 0, At, B0); PG8_BAR; PG8_SCHED;
            PG8_LDB(B1, 1, 1); PG8_STAGE(PG8_SB(1, 0), b3, voffB);
            PG8_BAR; PG8_WAIT_L(0); PG8_MMA(0, 1, At, B1); PG8_BAR;
            PG8_LDA(At, 1, 1); PG8_STAGE(PG8_SA(1, 0), a3, voffA);
            PG8_BAR; PG8_WAIT_L(0); PG8_MMA(1, 0, At, B0); PG8_BAR; PG8_SCHED;
            PG8_STAGE(PG8_SB(1, 1), b3 + hstepB, voffB);
            PG8_WAIT_V(6); PG8_BAR; PG8_MMA(1, 1, At, B1); PG8_BAR;
        }
        E(acc, cur, wr, wc, fr, fq);
        if (!has_next) break;
#pragma unroll
        for (int a = 0; a < 2; ++a)
#pragma unroll
            for (int b = 0; b < 2; ++b)
#pragma unroll
                for (int m = 0; m < 4; ++m)
#pragma unroll
                    for (int n = 0; n < 2; ++n) acc[a][b][m][n] = (f32x4){0.f, 0.f, 0.f, 0.f};
        cur = nxt; cA = nA; cB = nB; ++ui;
    }
    PG8_WAIT_V(0);
    if (wr == 0) PG8_BAR;
    PG8_BAR;
#undef PG8_SA
#undef PG8_SB
#undef PG8_STAGE
#undef PG8_LDA
#undef PG8_LDB
#undef PG8_MMA
#undef PG8_WAIT_V
#undef PG8_WAIT_L
#undef PG8_BAR
#undef PG8_SCHED
}

struct EpiProj {
    static constexpr bool PERM = true, HAS_MID = false; static constexpr int MID_T = -1;
    bf16_t* O; int ldc;
    DI void operator()(const f32x4 (&acc)[2][2][4][2], const Unit& u, int wr, int wc, int fr, int fq) const {
        const int row0 = u.pm * BM + wr * 64 + fr, col0 = u.pn * BM + wc * 32 + 8 * fq;
#pragma unroll
        for (int ai = 0; ai < 2; ++ai)
#pragma unroll
            for (int m = 0; m < 4; ++m) { bf16_t* rowp = O + (size_t)(row0 + ai * HALF + m * 16) * ldc + col0;
#pragma unroll
                for (int bj = 0; bj < 2; ++bj) { const f32x4 v0 = acc[ai][bj][m][0], v1 = acc[ai][bj][m][1];
                    u32x4 w; w.x = pk2(v0[0], v0[1]); w.y = pk2(v0[2], v0[3]); w.z = pk2(v1[0], v1[1]); w.w = pk2(v1[2], v1[3]);
                    *(u32x4*)(rowp + bj * HALF) = w; } }
    }
};
template <int MODE>
struct EpiMerge {
    static constexpr bool PERM = true, HAS_MID = false; static constexpr int MID_T = -1;
    bf16_t* P; const float* rstd;
    DI void operator()(const f32x4 (&acc)[2][2][4][2], const Unit& u, int wr, int wc, int fr, int fq) const {
        const int row0 = u.pm * BM + wr * 64 + fr, col0 = u.pn * BM + wc * 32 + 8 * fq;
#pragma unroll
        for (int ai = 0; ai < 2; ++ai)
#pragma unroll
            for (int m = 0; m < 4; ++m) { const int row = row0 + ai * HALF + m * 16; bf16_t* rowp = P + (size_t)row * LDP + col0;
                const float rs = (MODE == 0) ? rstd[row] : 1.f;
#pragma unroll
                for (int bj = 0; bj < 2; ++bj) { const f32x4 v0 = acc[ai][bj][m][0], v1 = acc[ai][bj][m][1];
                    const u32x4 gl = *(const u32x4*)(rowp + bj * HALF + (MODE == 0 ? C_GLS : C_GLN));
                    float o[8] = {v0[0], v0[1], v0[2], v0[3], v1[0], v1[1], v1[2], v1[3]};
                    const unsigned gw[4] = {gl.x, gl.y, gl.z, gl.w};
                    u32x4 prev = {0u, 0u, 0u, 0u};
                    if (MODE == 1) prev = *(const u32x4*)(rowp + bj * HALF);
                    const unsigned pw[4] = {prev.x, prev.y, prev.z, prev.w};
#pragma unroll
                    for (int j = 0; j < 4; ++j) {
                        o[2 * j] = o[2 * j] * rs * sigmoidf_(lo16(gw[j])) + (MODE == 1 ? lo16(pw[j]) : 0.f);
                        o[2 * j + 1] = o[2 * j + 1] * rs * sigmoidf_(hi16(gw[j])) + (MODE == 1 ? hi16(pw[j]) : 0.f); }
                    u32x4 w; w.x = pk2(o[0], o[1]); w.y = pk2(o[2], o[3]); w.z = pk2(o[4], o[5]); w.w = pk2(o[6], o[7]);
                    *(u32x4*)(rowp + bj * HALF) = w; asm volatile("" ::: "memory"); } }
    }
};
struct EpiMergeF {
    static constexpr bool PERM = true, HAS_MID = true; static constexpr int MID_T = 32;
    bf16_t* P; const float* rstd;
    DI void mid(f32x4 (&acc)[2][2][4][2], const Unit& u, int wr, int wc, int fr, int fq) const {
        const int row0 = opaque_i(u.pm * BM + wr * 64 + fr), col0 = opaque_i(u.pn * BM + wc * 32 + 8 * fq);
#pragma unroll
        for (int ai = 0; ai < 2; ++ai) {
            u32x4 gs[4][2], gn[4][2]; float rs[4];
#pragma unroll
            for (int m = 0; m < 4; ++m) { const int row = row0 + ai * HALF + m * 16; const bf16_t* rowp = P + (size_t)row * LDP + col0; rs[m] = rstd[row];
#pragma unroll
                for (int bj = 0; bj < 2; ++bj) { gs[m][bj] = *(const u32x4*)(rowp + bj * HALF + C_GLS); gn[m][bj] = *(const u32x4*)(rowp + bj * HALF + C_GLN); } }
#pragma unroll
            for (int m = 0; m < 4; ++m)
#pragma unroll
                for (int bj = 0; bj < 2; ++bj) {
                    const unsigned gsw[4] = {gs[m][bj].x, gs[m][bj].y, gs[m][bj].z, gs[m][bj].w}, gnw[4] = {gn[m][bj].x, gn[m][bj].y, gn[m][bj].z, gn[m][bj].w};
#pragma unroll
                    for (int j = 0; j < 4; ++j) {
                        const float r0 = rs[m] * (1.f + __expf(-lo16(gnw[j]))) * __builtin_amdgcn_rcpf(1.f + __expf(-lo16(gsw[j])));
                        const float r1 = rs[m] * (1.f + __expf(-hi16(gnw[j]))) * __builtin_amdgcn_rcpf(1.f + __expf(-hi16(gsw[j])));
                        acc[ai][bj][m][j >> 1][(j & 1) * 2] *= r0; acc[ai][bj][m][j >> 1][(j & 1) * 2 + 1] *= r1; } }
            asm volatile("" ::: "memory");
        }
    }
    DI void operator()(const f32x4 (&acc)[2][2][4][2], const Unit& u, int wr, int wc, int fr, int fq) const {
        const int row0 = u.pm * BM + wr * 64 + fr, col0 = u.pn * BM + wc * 32 + 8 * fq;
        u32x4 gn[2][4][2];
#pragma unroll
        for (int ai = 0; ai < 2; ++ai)
#pragma unroll
            for (int m = 0; m < 4; ++m) { const bf16_t* rowp = P + (size_t)(row0 + ai * HALF + m * 16) * LDP + col0;
#pragma unroll
                for (int bj = 0; bj < 2; ++bj) gn[ai][m][bj] = *(const u32x4*)(rowp + bj * HALF + C_GLN); }
#pragma unroll
        for (int ai = 0; ai < 2; ++ai)
#pragma unroll
            for (int m = 0; m < 4; ++m) { bf16_t* rowp = P + (size_t)(row0 + ai * HALF + m * 16) * LDP + col0;
#pragma unroll
                for (int bj = 0; bj < 2; ++bj) { const f32x4 v0 = acc[ai][bj][m][0], v1 = acc[ai][bj][m][1];
                    const unsigned gnw[4] = {gn[ai][m][bj].x, gn[ai][m][bj].y, gn[ai][m][bj].z, gn[ai][m][bj].w};
                    const float o[8] = {v0[0], v0[1], v0[2], v0[3], v1[0], v1[1], v1[2], v1[3]};
                    u32x4 w;
                    w.x = pk2(o[0] * sigmoidf_(lo16(gnw[0])), o[1] * sigmoidf_(hi16(gnw[0]))); w.y = pk2(o[2] * sigmoidf_(lo16(gnw[1])), o[3] * sigmoidf_(hi16(gnw[1])));
                    w.z = pk2(o[4] * sigmoidf_(lo16(gnw[2])), o[5] * sigmoidf_(hi16(gnw[2]))); w.w = pk2(o[6] * sigmoidf_(lo16(gnw[3])), o[7] * sigmoidf_(hi16(gnw[3])));
                    *(u32x4*)(rowp + bj * HALF) = w; } }
    }
};
struct EpiOut {
    static constexpr bool PERM = false, HAS_MID = false; static constexpr int MID_T = -1;
    float* C; const float* X;
    DI void operator()(const f32x4 (&acc)[2][2][4][2], const Unit& u, int wr, int wc, int fr, int fq) const {
        const int row0 = u.pm * BM + wr * 64 + fr, col0 = u.pn * BM + wc * 32 + 4 * fq;
#pragma unroll
        for (int ai = 0; ai < 2; ++ai) {
            f32x4 xv[4][2][2];
#pragma unroll
            for (int m = 0; m < 4; ++m) { const size_t off = (size_t)(row0 + ai * HALF + m * 16) * DM + col0;
#pragma unroll
                for (int bj = 0; bj < 2; ++bj)
#pragma unroll
                    for (int n = 0; n < 2; ++n) xv[m][bj][n] = *(const f32x4*)(X + off + bj * HALF + n * 16); }
#pragma unroll
            for (int m = 0; m < 4; ++m) { const size_t off = (size_t)(row0 + ai * HALF + m * 16) * DM + col0;
#pragma unroll
                for (int bj = 0; bj < 2; ++bj)
#pragma unroll
                    for (int n = 0; n < 2; ++n) *(f32x4*)(C + off + bj * HALF + n * 16) = acc[ai][bj][m][n] + xv[m][bj][n]; }
            asm volatile("" ::: "memory");
        }
    }
};
}

DI int win_srccol(int j) {
    if (j < 5120) return j;
    if (j < 10752) return j + 32;
    if (j < 14848) return j + 80;
    if (j < 14880) return j - 14848 + 5120;
    if (j < 14928) return j - 14880 + 10784;
    return -1;
}
DI void transpose_tile(const float* src, int ldsrc, bf16_t* dst, int lddst, int k0, int n0, int mode, const float* rowscale, float* tile) {
    const int tid = opaque_tid();
    {
        const int r = tid >> 4, c4 = (tid & 15) * 4;
#pragma unroll
        for (int q = 0; q < 2; ++q) {
            const int rr = r + 32 * q; const int jd = n0 + c4; const int js = mode ? win_srccol(jd) : jd;
            f32x4 v = {0.f, 0.f, 0.f, 0.f};
            if (js >= 0) v = *(const f32x4*)(src + (size_t)(k0 + rr) * ldsrc + js);
            if (rowscale) { const float sc = rowscale[k0 + rr]; v = v * sc; }
            tile[rr * 65 + c4 + 0] = v[0]; tile[rr * 65 + c4 + 1] = v[1]; tile[rr * 65 + c4 + 2] = v[2]; tile[rr * 65 + c4 + 3] = v[3];
        }
    }
    LDS_BAR();
    {
        const int n = tid >> 3, k8 = (tid & 7) * 8;
        u32x4 w;
        w.x = pk2(tile[(k8 + 0) * 65 + n], tile[(k8 + 1) * 65 + n]); w.y = pk2(tile[(k8 + 2) * 65 + n], tile[(k8 + 3) * 65 + n]);
        w.z = pk2(tile[(k8 + 4) * 65 + n], tile[(k8 + 5) * 65 + n]); w.w = pk2(tile[(k8 + 6) * 65 + n], tile[(k8 + 7) * 65 + n]);
        *(u32x4*)(dst + (size_t)(n0 + n) * lddst + k0 + k8) = w;
    }
    LDS_BAR();
}

DI void phase_prep(const Params& P, unsigned char* smem) {
    const int tid = opaque_tid(), lane = tid & 63, wave = tid >> 6;
    for (int row = blockIdx.x * 8 + wave; row < NTOK; row += gridDim.x * 8) {
        const f32x4* xr = (const f32x4*)(P.x + (size_t)row * DM);
        f32x4 v[8]; float s = 0.f;
#pragma unroll
        for (int j = 0; j < 8; ++j) { v[j] = xr[lane + 64 * j]; s += v[j][0] * v[j][0] + v[j][1] * v[j][1] + v[j][2] * v[j][2] + v[j][3] * v[j][3]; }
        s = wave_sum(s);
        const float rstd = 1.f / sqrtf(s * (1.f / DM) + EPSF);
        u32x2* o = (u32x2*)(P_h + (size_t)row * DM);
#pragma unroll
        for (int j = 0; j < 8; ++j) { const f32x4 w = ((const f32x4*)P.norm_w)[lane + 64 * j]; u32x2 r; r.x = pk2(v[j][0] * rstd * w[0], v[j][1] * rstd * w[1]); r.y = pk2(v[j][2] * rstd * w[2], v[j][3] * rstd * w[3]); o[lane + 64 * j] = r; }
    }
    float* tile = (float*)smem;
    constexpr int I_WIN = 32 * (LDP / 64), I_W1 = 64 * 2, I_W2 = 2 * 2;
    constexpr int NIT = I_WIN + 2 * I_W1 + 2 * I_W2 + 32;
    for (int it = blockIdx.x; it < NIT; it += gridDim.x) {
        int r = it;
        if (r < I_WIN) { const int kb = r & 31, nb = r >> 5; transpose_tile(P.w_in, INDIM, P_winT, DM, kb * 64, nb * 64, 1, nullptr, tile); continue; } r -= I_WIN;
        if (r < I_W1) { transpose_tile(P.cmp_w1_k, 128, P_w1kT, 4096, (r >> 1) * 64, (r & 1) * 64, 0, nullptr, tile); continue; } r -= I_W1;
        if (r < I_W1) { transpose_tile(P.cmp_w1_v, 128, P_w1vT, 4096, (r >> 1) * 64, (r & 1) * 64, 0, nullptr, tile); continue; } r -= I_W1;
        if (r < I_W2) { transpose_tile(P.cmp_w2_k, 128, P_w2kT, 128, (r >> 1) * 64, (r & 1) * 64, 0, nullptr, tile); continue; } r -= I_W2;
        if (r < I_W2) { transpose_tile(P.cmp_w2_v, 128, P_w2vT, 128, (r >> 1) * 64, (r & 1) * 64, 0, nullptr, tile); continue; } r -= I_W2;
        {
            const int which = r >> 4, n0 = (r & 15) * 8;
            const float* pe = which ? P.cmp_pe_v : P.cmp_pe_k; const float* w1 = which ? P.cmp_w1_v : P.cmp_w1_k; const float* b1 = which ? P.cmp_b1_v : P.cmp_b1_k; float* bo = which ? P_biasv : P_biask;
            float acc8[8];
#pragma unroll
            for (int j = 0; j < 8; ++j) acc8[j] = 0.f;
#pragma unroll
            for (int i = 0; i < 8; ++i) { const int kk = tid + 512 * i; const float pv = pe[kk]; const f32x4 wa = *(const f32x4*)(w1 + (size_t)kk * 128 + n0), wb = *(const f32x4*)(w1 + (size_t)kk * 128 + n0 + 4);
                acc8[0] += pv * wa[0]; acc8[1] += pv * wa[1]; acc8[2] += pv * wa[2]; acc8[3] += pv * wa[3]; acc8[4] += pv * wb[0]; acc8[5] += pv * wb[1]; acc8[6] += pv * wb[2]; acc8[7] += pv * wb[3]; }
#pragma unroll
            for (int j = 0; j < 8; ++j) acc8[j] = wave_sum(acc8[j]);
            if (lane == 0) {
#pragma unroll
                for (int j = 0; j < 8; ++j) tile[wave * 8 + j] = acc8[j]; }
            __syncthreads();
            if (tid < 8) { float t = 0.f;
#pragma unroll
                for (int w = 0; w < 8; ++w) t += tile[w * 8 + tid];
                bo[n0 + tid] = b1[n0 + tid] + t; }
            __syncthreads();
        }
    }
}

constexpr int RS = 272;
constexpr int SSD_BS = 0, SSD_BWT = 34816, SSD_CS = 69632, SSD_XT = 104448, SSD_ST = 121856, SSD_CUM = 139264, SSD_WSC = 139776, SSD_DTV = 140288;

DI void phase_bcconv(const Params& P) {
    const int tid = opaque_tid();
    for (int it = blockIdx.x; it < 256; it += gridDim.x) {
        const int b = it >> 4, slab = it & 15; const int cg = tid & 7, seg = tid >> 3;
        const int c = 2048 + slab * 64 + cg * 8;
        bf16_t* base = P_proj + (size_t)b * TT * LDP + C_X + c;
        float w[4][8], bias[8];
#pragma unroll
        for (int k = 0; k < 4; ++k) { const f32x4 a = *(const f32x4*)(P.conv_w + k * 3072 + c), bb = *(const f32x4*)(P.conv_w + k * 3072 + c + 4);
            w[k][0] = a[0]; w[k][1] = a[1]; w[k][2] = a[2]; w[k][3] = a[3]; w[k][4] = bb[0]; w[k][5] = bb[1]; w[k][6] = bb[2]; w[k][7] = bb[3]; }
        { const f32x4 a = *(const f32x4*)(P.conv_b + c), bb = *(const f32x4*)(P.conv_b + c + 4); bias[0] = a[0]; bias[1] = a[1]; bias[2] = a[2]; bias[3] = a[3]; bias[4] = bb[0]; bias[5] = bb[1]; bias[6] = bb[2]; bias[7] = bb[3]; }
        float h[3][8];
        const int ts = seg * 32;
#pragma unroll
        for (int r = 0; r < 3; ++r) { const int t = ts - 3 + r; u32x4 row = {0u, 0u, 0u, 0u}; if (t >= 0) row = *(const u32x4*)(base + (size_t)t * LDP);
            const unsigned uw[4] = {row.x, row.y, row.z, row.w};
#pragma unroll
            for (int j = 0; j < 4; ++j) { h[r][2 * j] = lo16(uw[j]); h[r][2 * j + 1] = hi16(uw[j]); } }
        __syncthreads();
#pragma unroll 1
        for (int i = 0; i < 32; i += 8) {
            u32x4 rows[8];
#pragma unroll
            for (int q = 0; q < 8; ++q) rows[q] = *(const u32x4*)(base + (size_t)(ts + i + q) * LDP);
#pragma unroll
            for (int q = 0; q < 8; ++q) {
                const unsigned uw[4] = {rows[q].x, rows[q].y, rows[q].z, rows[q].w}; float cur[8], o[8];
#pragma unroll
                for (int j = 0; j < 4; ++j) { cur[2 * j] = lo16(uw[j]); cur[2 * j + 1] = hi16(uw[j]); }
#pragma unroll
                for (int j = 0; j < 8; ++j) { o[j] = siluf_(bias[j] + w[0][j] * h[0][j] + w[1][j] * h[1][j] + w[2][j] * h[2][j] + w[3][j] * cur[j]); h[0][j] = h[1][j]; h[1][j] = h[2][j]; h[2][j] = cur[j]; }
                u32x4 ov; ov.x = pk2(o[0], o[1]); ov.y = pk2(o[2], o[3]); ov.z = pk2(o[4], o[5]); ov.w = pk2(o[6], o[7]);
                *(u32x4*)(base + (size_t)(ts + i + q) * LDP) = ov;
            }
        }
        __syncthreads();
    }
}

constexpr int SSD_WCV = 140800;

template <int NT, int ROFF, int NR, int WS = 320>
DI void conv_regs(const u32x4 (&rows)[NR], const float* wl  , float (&out)[NT][8]) {
    float w[5][8];
#pragma unroll
    for (int k = 0; k < 5; ++k) { const f32x4 a = *(const f32x4*)(wl + k * WS), b = *(const f32x4*)(wl + k * WS + 4);
        w[k][0] = a[0]; w[k][1] = a[1]; w[k][2] = a[2]; w[k][3] = a[3]; w[k][4] = b[0]; w[k][5] = b[1]; w[k][6] = b[2]; w[k][7] = b[3]; }
#pragma unroll
    for (int tk = 0; tk < NT; ++tk)
#pragma unroll
        for (int c = 0; c < 8; ++c) out[tk][c] = w[4][c];
#pragma unroll
    for (int r = 0; r < NT + 3; ++r) {
        const u32x4 row = rows[ROFF + r]; const unsigned uw[4] = {row.x, row.y, row.z, row.w};
        float u[8];
#pragma unroll
        for (int j = 0; j < 4; ++j) { u[2 * j] = lo16(uw[j]); u[2 * j + 1] = hi16(uw[j]); }
#pragma unroll
        for (int k = 0; k < 4; ++k) { const int tk = r - k;
            if (tk >= 0 && tk < NT) {
#pragma unroll
                for (int c = 0; c < 8; ++c) out[tk][c] += w[k][c] * u[c]; } }
    }
#pragma unroll
    for (int tk = 0; tk < NT; ++tk)
#pragma unroll
        for (int c = 0; c < 8; ++c) out[tk][c] = siluf_(out[tk][c]);
}

DI void ssd_item(const Params& P, unsigned char* smem, int b, int hd) {
    const int tid0 = opaque_tid();
    const int g = hd >> 3;
    const float Aneg = -__expf(P.a_log[hd]), dtb = P.dt_bias[hd], Dsk = P.d_skip[hd];
    const bf16_t* pbase = P_proj + (size_t)b * TT * LDP;
    float* cum = (float*)(smem + SSD_CUM); float* wsc = (float*)(smem + SSD_WSC); float* dtv = (float*)(smem + SSD_DTV); float* wcv = (float*)(smem + SSD_WCV);
#define SSD_ROLES(tid) \
    const int lane = tid & 63, wave = tid >> 6, l32o = lane & 31, hho = lane >> 5, l32 = l32o, hh = hho; \
    const int lt = wave & 3, ph = wave >> 2; \
    const int cgi = tid & 31, run = tid >> 5; \
    const int chbc = (cgi < 16 ? 2048 + g * 128 + cgi * 8 : 2560 + g * 128 + (cgi - 16) * 8); \
    const int cgx = tid & 7, runx = tid >> 3; const int chx = hd * 64 + cgx * 8;
    __syncthreads();
    for (int i = tid0; i < 5 * 320; i += 512) { const int k = i / 320, c = i % 320; const int ch = c < 128 ? 2048 + g * 128 + c : (c < 256 ? 2560 + g * 128 + (c - 128) : hd * 64 + (c - 256));
        wcv[i] = (k < 4) ? P.conv_w[k * 3072 + ch] : P.conv_b[ch]; }
    f32x16 state;
#pragma unroll
    for (int i = 0; i < 16; ++i) state[i] = 0.f;
    u32x4 rbc[8], rx[5]; u32x2 zr[4]; float dr0 = 0.f, dr1 = 0.f;
#define SSD_BAR() do { asm volatile("s_waitcnt lgkmcnt(0)" ::: "memory"); __builtin_amdgcn_s_barrier(); asm volatile("" ::: "memory"); } while (0)
#define SSD_ISSUE_Z(T0) do { _Pragma("unroll") for (int ig = 0; ig < 4; ++ig) zr[ig] = *(const u32x2*)(pbase + (size_t)((T0) + 32 * lt + l32o) * LDP + C_Z + hd * 64 + 32 * ph + 8 * ig + 4 * hho); } while (0)
#define SSD_ISSUE(T0) do { \
        _Pragma("unroll") for (int r = 0; r < 8; ++r) { const int t = (T0) + run * 8 + r; rbc[r] = *(const u32x4*)(pbase + (size_t)t * LDP + C_X + chbc); } \
        _Pragma("unroll") for (int r = 0; r < 5; ++r) { const int t = (T0) + runx * 2 - 3 + r; rx[r] = (u32x4){0u, 0u, 0u, 0u}; if (t >= 0) rx[r] = *(const u32x4*)(pbase + (size_t)t * LDP + C_X + chx); } \
        if (wave == 0) { dr0 = bf2f(pbase[(size_t)((T0) + lane) * LDP + C_DT + hd]); dr1 = bf2f(pbase[(size_t)((T0) + 64 + lane) * LDP + C_DT + hd]); } } while (0)
    { SSD_ROLES(tid0) SSD_ISSUE(0); SSD_ISSUE_Z(0); }

    for (int c = 0; c < 16; ++c) {
        const int t0 = c * 128; const int tidc = opaque_i(tid0);
        SSD_ROLES(tidc)
        SSD_BAR();
        if (wave == 0) {
            const float r0 = dr0 + dtb, r1 = dr1 + dtb;
            const float d0 = r0 > 20.f ? r0 : log1pf(__expf(r0)), d1 = r1 > 20.f ? r1 : log1pf(__expf(r1));
            float c0 = d0 * Aneg, c1 = d1 * Aneg;
#pragma unroll
            for (int o = 1; o < 64; o <<= 1) { const float a0 = __shfl_up(c0, o), a1 = __shfl_up(c1, o); if (lane >= o) { c0 += a0; c1 += a1; } }
            const float tot0 = __shfl(c0, 63); c1 += tot0;
            const float last = __shfl(c1, 63);
            cum[lane] = c0; cum[64 + lane] = c1; dtv[lane] = d0; dtv[64 + lane] = d1;
            wsc[lane] = d0 * __expf(last - c0); wsc[64 + lane] = d1 * __expf(last - c1);
        }
        {
            const int o1 = opaque_i((32 * ph + 4 * hh) * RS + (32 * lt + l32) * 2);
#pragma unroll
            for (int i = 0; i < 16; ++i) *(bf16_t*)(smem + SSD_ST + o1 + ((i & 3) + 8 * (i >> 2)) * RS) = f2bf(state[i]);
        }
        SSD_BAR();
        {
            if (cgi < 16) {
                const int n0 = cgi * 8;
#pragma unroll
                for (int r = 0; r < 8; ++r) *(u32x4*)(smem + SSD_BS + (run * 8 + r) * RS + n0 * 2) = rbc[r];
                const f32x4 wsa = *(const f32x4*)(wsc + run * 8), wsb = *(const f32x4*)(wsc + run * 8 + 4);
                const float ws8[8] = {wsa[0], wsa[1], wsa[2], wsa[3], wsb[0], wsb[1], wsb[2], wsb[3]};
#pragma unroll
                for (int cc = 0; cc < 8; ++cc) { float v[8];
#pragma unroll
                    for (int r = 0; r < 8; ++r) { const unsigned wd = (cc >> 1) == 0 ? rbc[r].x : ((cc >> 1) == 1 ? rbc[r].y : ((cc >> 1) == 2 ? rbc[r].z : rbc[r].w)); v[r] = ((cc & 1) ? hi16(wd) : lo16(wd)) * ws8[r]; }
                    u32x4 w; w.x = pk2(v[0], v[1]); w.y = pk2(v[2], v[3]); w.z = pk2(v[4], v[5]); w.w = pk2(v[6], v[7]);
                    *(u32x4*)(smem + SSD_BWT + (n0 + cc) * RS + run * 16) = w; }
            } else {
                const int n0 = (cgi - 16) * 8;
#pragma unroll
                for (int r = 0; r < 8; ++r) *(u32x4*)(smem + SSD_CS + (run * 8 + r) * RS + n0 * 2) = rbc[r];
            }
            float ox[2][8];
            conv_regs<2, 0, 5>(rx, wcv + 256 + cgx * 8, ox);
#pragma unroll
            for (int cc = 0; cc < 8; ++cc) *(unsigned*)(smem + SSD_XT + (cgx * 8 + cc) * RS + runx * 4) = pk2(ox[0][cc], ox[1][cc]);
        }
        SSD_BAR();
        if (c < 15) SSD_ISSUE(t0 + 128);
        {
            const int l32 = opaque_i(l32o), hh = opaque_i(hho);
            const int l = 32 * lt + l32;
            const unsigned char* cfp = smem + SSD_CS + l * RS + 16 * hh;
#define CF(ks) (*(const bf16x8*)(cfp + 32 * (ks)))
            f32x16 acc;
#pragma unroll
            for (int i = 0; i < 16; ++i) acc[i] = 0.f;
#pragma unroll
            for (int ks = 0; ks < 8; ++ks) { const bf16x8 a = *(const bf16x8*)(smem + SSD_ST + (32 * ph + l32) * RS + (16 * ks + 8 * hh) * 2); acc = MFMA32(a, CF(ks), acc); }
            const float cl = cum[l];
            { const float e = __expf(cl);
#pragma unroll
              for (int i = 0; i < 16; ++i) acc[i] *= e; }
            for (int st = 0; st <= lt; ++st) {
                f32x16 S;
#pragma unroll
                for (int i = 0; i < 16; ++i) S[i] = 0.f;
#pragma unroll
                for (int ks = 0; ks < 8; ++ks) { const bf16x8 a = *(const bf16x8*)(smem + SSD_BS + (32 * st + l32) * RS + (16 * ks + 8 * hh) * 2); S = MFMA32(a, CF(ks), S); }
#pragma unroll
                for (int ig = 0; ig < 4; ++ig) { const int s0 = 32 * st + 8 * ig + 4 * hh; const f32x4 cs = *(const f32x4*)(cum + s0), dv = *(const f32x4*)(dtv + s0);
#pragma unroll
                    for (int j = 0; j < 4; ++j) { const float dec = __expf(fminf(cl - cs[j], 0.f)) * dv[j]; S[4 * ig + j] = (s0 + j <= l) ? S[4 * ig + j] * dec : 0.f; } }
#pragma unroll
                for (int s2 = 0; s2 < 2; ++s2) {
                    const bf16x8 mf = pack8(S, s2);
                    const unsigned char* xp = smem + SSD_XT + (32 * ph + l32) * RS + (32 * st + 16 * s2 + 4 * hh) * 2;
                    const bf16x8 a = cat44(*(const s16x4*)xp, *(const s16x4*)(xp + 16));
                    acc = MFMA32(a, mf, acc);
                }
            }
            const size_t tok = (size_t)b * TT + t0 + l; float ss = 0.f;
            const int xo = opaque_i((32 * ph + 4 * hh) * RS + l * 2);
#pragma unroll
            for (int ig = 0; ig < 4; ++ig) { const int p0 = 32 * ph + 8 * ig + 4 * hh;
                const u32x2 zz = zr[ig];
                const float zf[4] = {lo16(zz.x), hi16(zz.x), lo16(zz.y), hi16(zz.y)}; float y[4];
#pragma unroll
                for (int j = 0; j < 4; ++j) { const float xv = bf2f(*(const bf16_t*)(smem + SSD_XT + xo + (8 * ig + j) * RS)); y[j] = (acc[4 * ig + j] + Dsk * xv) * siluf_(zf[j]); ss += y[j] * y[j]; }
                u32x2 w; w.x = pk2(y[0], y[1]); w.y = pk2(y[2], y[3]);
                *(u32x2*)(P_yg + tok * 4096 + hd * 64 + p0) = w; }
            ss += __shfl_xor(ss, 32);
            if (hh == 0) P_part[tok * 64 + hd * 2 + ph] = ss;
            { const float e = __expf(cum[127]);
#pragma unroll
              for (int i = 0; i < 16; ++i) state[i] *= e; }
#pragma unroll
            for (int ks = 0; ks < 8; ++ks) {
                const bf16x8 a = *(const bf16x8*)(smem + SSD_XT + (32 * ph + l32) * RS + (16 * ks + 8 * hh) * 2);
                const bf16x8 bb = *(const bf16x8*)(smem + SSD_BWT + (32 * lt + l32) * RS + (16 * ks + 8 * hh) * 2);
                state = MFMA32(a, bb, state);
            }
            if (c < 15) SSD_ISSUE_Z(t0 + 128);
        }
    }
#undef SSD_ISSUE_Z
#undef SSD_ISSUE
#undef SSD_BAR
#undef CF
#undef SSD_ROLES
}

constexpr int RS2 = 144;
constexpr int S2_BS = 0, S2_CS = 17408, S2_HALF0 = 34816, S2_HSTRIDE = 47104;
constexpr int S2_BWT = 0, S2_XT = 18432, S2_ST = 27648, S2_CUM = 45056, S2_WSC = 45312, S2_DTV = 45568, S2_WCV = 45824;

DI void ssd_pair_item(const Params& P, unsigned char* smem, int b, int hp) {
    const int tid0 = opaque_tid();
    const int hd = 2 * hp + (tid0 >> 8), g = hp >> 2;
    const float Aneg = -__expf(P.a_log[hd]), dtb = P.dt_bias[hd], Dsk = P.d_skip[hd];
    const bf16_t* pbase = P_proj + (size_t)b * TT * LDP;
    unsigned char* hb = smem + S2_HALF0 + (tid0 >> 8) * S2_HSTRIDE;
    float* cum = (float*)(hb + S2_CUM); float* wsc = (float*)(hb + S2_WSC); float* dtv = (float*)(hb + S2_DTV); float* wcv = (float*)(hb + S2_WCV);
#define S2_ROLES(tid) \
    const int lane = tid & 63, wave = tid >> 6, wl = wave & 3, half = wave >> 2, l32o = lane & 31, hho = lane >> 5, l32 = l32o, hh = hho; \
    const int lt = wl & 1, ph = wl >> 1, tidh = tid & 255; \
    const int cg = tidh & 15, run = tidh >> 4; const int chb = 2048 + g * 128 + cg * 8, chc = 2560 + g * 128 + cg * 8; \
    const int cgx = tidh & 7, runx = tidh >> 3; const int chx = hd * 64 + cgx * 8;
    __syncthreads();
    for (int i = (tid0 & 255); i < 5 * 64; i += 256) { const int k = i >> 6, c = i & 63; const int ch = hd * 64 + c; wcv[i] = (k < 4) ? P.conv_w[k * 3072 + ch] : P.conv_b[ch]; }
    f32x16 state[2];
#pragma unroll
    for (int i = 0; i < 16; ++i) { state[0][i] = 0.f; state[1][i] = 0.f; }
    u32x4 rb[4], rc[4], rx[5]; u32x2 zr[4]; float dr0 = 0.f;
#pragma unroll
    for (int r = 0; r < 4; ++r) rc[r] = (u32x4){0u, 0u, 0u, 0u};
#define S2_BAR() do { asm volatile("s_waitcnt lgkmcnt(0)" ::: "memory"); __builtin_amdgcn_s_barrier(); asm volatile("" ::: "memory"); } while (0)
#define S2_ISSUE_Z(T0) do { _Pragma("unroll") for (int ig = 0; ig < 4; ++ig) zr[ig] = *(const u32x2*)(pbase + (size_t)((T0) + 32 * lt + l32o) * LDP + C_Z + hd * 64 + 32 * ph + 8 * ig + 4 * hho); } while (0)
#define S2_ISSUE(T0) do { \
        _Pragma("unroll") for (int r = 0; r < 4; ++r) { const int t = (T0) + run * 4 + r; rb[r] = *(const u32x4*)(pbase + (size_t)t * LDP + C_X + chb); if (half) rc[r] = *(const u32x4*)(pbase + (size_t)t * LDP + C_X + chc); } \
        _Pragma("unroll") for (int r = 0; r < 5; ++r) { const int t = (T0) + runx * 2 - 3 + r; rx[r] = (u32x4){0u, 0u, 0u, 0u}; if (t >= 0) rx[r] = *(const u32x4*)(pbase + (size_t)t * LDP + C_X + chx); } \
        if (wl == 0) dr0 = bf2f(pbase[(size_t)((T0) + lane) * LDP + C_DT + hd]); } while (0)
    { S2_ROLES(tid0) S2_ISSUE(0); S2_ISSUE_Z(0); }

    for (int c = 0; c < 32; ++c) {
        const int t0 = c * 64; const int tidc = opaque_i(tid0);
        S2_ROLES(tidc)
        S2_BAR();
        if (wl == 0) {
            const float r0 = dr0 + dtb;
            const float d0 = r0 > 20.f ? r0 : log1pf(__expf(r0));
            float c0 = d0 * Aneg;
#pragma unroll
            for (int o = 1; o < 64; o <<= 1) { const float a0 = __shfl_up(c0, o); if (lane >= o) c0 += a0; }
            const float last = __shfl(c0, 63);
            cum[lane] = c0; dtv[lane] = d0; wsc[lane] = d0 * __expf(last - c0);
        }
        {
#pragma unroll
            for (int q = 0; q < 2; ++q) {
                const int o1 = opaque_i((32 * ph + 4 * hh) * RS + (32 * (2 * lt + q) + l32) * 2);
#pragma unroll
                for (int i = 0; i < 16; ++i) *(bf16_t*)(hb + S2_ST + o1 + ((i & 3) + 8 * (i >> 2)) * RS) = f2bf(state[q][i]);
            }
        }
        S2_BAR();
        {
            if (half == 0) {
#pragma unroll
                for (int r = 0; r < 4; ++r) *(u32x4*)(smem + S2_BS + (run * 4 + r) * RS + cg * 16) = rb[r];
            } else {
#pragma unroll
                for (int r = 0; r < 4; ++r) *(u32x4*)(smem + S2_CS + (run * 4 + r) * RS + cg * 16) = rc[r];
            }
            const f32x4 ws4 = *(const f32x4*)(wsc + run * 4);
#pragma unroll
            for (int cc = 0; cc < 8; ++cc) { float v[4];
#pragma unroll
                for (int r = 0; r < 4; ++r) { const unsigned wd = (cc >> 1) == 0 ? rb[r].x : ((cc >> 1) == 1 ? rb[r].y : ((cc >> 1) == 2 ? rb[r].z : rb[r].w)); v[r] = ((cc & 1) ? hi16(wd) : lo16(wd)) * ws4[r]; }
                u32x2 w; w.x = pk2(v[0], v[1]); w.y = pk2(v[2], v[3]);
                *(u32x2*)(hb + S2_BWT + (cg * 8 + cc) * RS2 + run * 8) = w; }
            float ox[2][8];
            conv_regs<2, 0, 5, 64>(rx, wcv + cgx * 8, ox);
#pragma unroll
            for (int cc = 0; cc < 8; ++cc) *(unsigned*)(hb + S2_XT + (cgx * 8 + cc) * RS2 + runx * 4) = pk2(ox[0][cc], ox[1][cc]);
        }
        S2_BAR();
        if (c < 31) S2_ISSUE(t0 + 64);
        {
            const int l32 = opaque_i(l32o), hh = opaque_i(hho);
            const int l = 32 * lt + l32;
            const unsigned char* cfp = smem + S2_CS + l * RS + 16 * hh;
#define CF2(ks) (*(const bf16x8*)(cfp + 32 * (ks)))
            f32x16 acc;
#pragma unroll
            for (int i = 0; i < 16; ++i) acc[i] = 0.f;
            __builtin_amdgcn_s_setprio(1);
#pragma unroll
            for (int ks = 0; ks < 8; ++ks) { const bf16x8 a = *(const bf16x8*)(hb + S2_ST + (32 * ph + l32) * RS + (16 * ks + 8 * hh) * 2); acc = MFMA32(a, CF2(ks), acc); }
            __builtin_amdgcn_s_setprio(0);
            const float cl = cum[l];
            { const float e = __expf(cl);
#pragma unroll
              for (int i = 0; i < 16; ++i) acc[i] *= e; }
            for (int st = 0; st <= lt; ++st) {
                f32x16 S;
#pragma unroll
                for (int i = 0; i < 16; ++i) S[i] = 0.f;
                __builtin_amdgcn_s_setprio(1);
#pragma unroll
                for (int ks = 0; ks < 8; ++ks) { const bf16x8 a = *(const bf16x8*)(smem + S2_BS + (32 * st + l32) * RS + (16 * ks + 8 * hh) * 2); S = MFMA32(a, CF2(ks), S); }
                __builtin_amdgcn_s_setprio(0);
#pragma unroll
                for (int ig = 0; ig < 4; ++ig) { const int s0 = 32 * st + 8 * ig + 4 * hh; const f32x4 cs = *(const f32x4*)(cum + s0), dv = *(const f32x4*)(dtv + s0);
#pragma unroll
                    for (int j = 0; j < 4; ++j) { const float dec = __expf(fminf(cl - cs[j], 0.f)) * dv[j]; S[4 * ig + j] = (s0 + j <= l) ? S[4 * ig + j] * dec : 0.f; } }
#pragma unroll
                for (int s2 = 0; s2 < 2; ++s2) {
                    const bf16x8 mf = pack8(S, s2);
                    const unsigned char* xp = hb + S2_XT + (32 * ph + l32) * RS2 + (32 * st + 16 * s2 + 4 * hh) * 2;
                    const bf16x8 a = cat44(*(const s16x4*)xp, *(const s16x4*)(xp + 16));
                    acc = MFMA32(a, mf, acc);
                }
            }
            const size_t tok = (size_t)b * TT + t0 + l; float ss = 0.f;
            const int xo = opaque_i((32 * ph + 4 * hh) * RS2 + l * 2);
#pragma unroll
            for (int ig = 0; ig < 4; ++ig) { const int p0 = 32 * ph + 8 * ig + 4 * hh;
                const u32x2 zz = zr[ig];
                const float zf[4] = {lo16(zz.x), hi16(zz.x), lo16(zz.y), hi16(zz.y)}; float y[4];
#pragma unroll
                for (int j = 0; j < 4; ++j) { const float xv = bf2f(*(const bf16_t*)(hb + S2_XT + xo + (8 * ig + j) * RS2)); y[j] = (acc[4 * ig + j] + Dsk * xv) * siluf_(zf[j]); ss += y[j] * y[j]; }
                u32x2 w; w.x = pk2(y[0], y[1]); w.y = pk2(y[2], y[3]);
                *(u32x2*)(P_yg + tok * 4096 + hd * 64 + p0) = w; }
            ss += __shfl_xor(ss, 32);
            if (hh == 0) P_part[tok * 64 + hd * 2 + ph] = ss;
            { const float e = __expf(cum[63]);
#pragma unroll
              for (int i = 0; i < 16; ++i) { state[0][i] *= e; state[1][i] *= e; } }
            __builtin_amdgcn_s_setprio(1);
#pragma unroll
            for (int ks = 0; ks < 4; ++ks) {
                const bf16x8 a = *(const bf16x8*)(hb + S2_XT + (32 * ph + l32) * RS2 + (16 * ks + 8 * hh) * 2);
#pragma unroll
                for (int q = 0; q < 2; ++q) { const bf16x8 bb = *(const bf16x8*)(hb + S2_BWT + (32 * (2 * lt + q) + l32) * RS2 + (16 * ks + 8 * hh) * 2); state[q] = MFMA32(a, bb, state[q]); }
            }
            __builtin_amdgcn_s_setprio(0);
            if (c < 31) S2_ISSUE_Z(t0 + 64);
        }
    }
#undef S2_ISSUE_Z
#undef S2_ISSUE
#undef S2_BAR
#undef CF2
#undef S2_ROLES
}

DI void knorm16(const u32x4 a, const u32x4 c2, const float* nw, u32x4& o0, u32x4& o1) {
    const unsigned uw[8] = {a.x, a.y, a.z, a.w, c2.x, c2.y, c2.z, c2.w}; float v[16]; float s = 0.f;
#pragma unroll
    for (int j = 0; j < 8; ++j) { v[2 * j] = lo16(uw[j]); v[2 * j + 1] = hi16(uw[j]); s += v[2 * j] * v[2 * j] + v[2 * j + 1] * v[2 * j + 1]; }
    s += __shfl_xor(s, 1); s += __shfl_xor(s, 2); s += __shfl_xor(s, 4);
    const float rstd = 1.f / sqrtf(s * (1.f / 128.f) + EPSF);
    o0.x = pk2(v[0] * rstd * nw[0], v[1] * rstd * nw[1]); o0.y = pk2(v[2] * rstd * nw[2], v[3] * rstd * nw[3]); o0.z = pk2(v[4] * rstd * nw[4], v[5] * rstd * nw[5]); o0.w = pk2(v[6] * rstd * nw[6], v[7] * rstd * nw[7]);
    o1.x = pk2(v[8] * rstd * nw[8], v[9] * rstd * nw[9]); o1.y = pk2(v[10] * rstd * nw[10], v[11] * rstd * nw[11]); o1.z = pk2(v[12] * rstd * nw[12], v[13] * rstd * nw[13]); o1.w = pk2(v[14] * rstd * nw[14], v[15] * rstd * nw[15]);
}
DI void kvprep_item(const Params& P, unsigned char* smem, int item) {
    const int tid = opaque_tid(); const int tt = item & 31, g = (item >> 5) & 1, b = item >> 6; const int t0 = tt * 64;
    bf16_t* pb = P_proj + ((size_t)b * TT + t0) * LDP;
    const int tk = tid >> 3, part = tid & 7;
    bf16_t* kp0 = pb + (size_t)tk * LDP + C_KSLC + g * 128 + part * 16; bf16_t* kp1 = pb + (size_t)tk * LDP + C_KWIN + g * 128 + part * 16;
    const bf16_t* vp0 = pb + (size_t)tk * LDP + C_VSLC + g * 128 + part * 16; const bf16_t* vp1 = pb + (size_t)tk * LDP + C_VWIN + g * 128 + part * 16;
    const u32x4 k0a = *(const u32x4*)kp0, k0b = *(const u32x4*)(kp0 + 8), k1a = *(const u32x4*)kp1, k1b = *(const u32x4*)(kp1 + 8);
    const u32x4 v0a = *(const u32x4*)vp0, v0b = *(const u32x4*)(vp0 + 8), v1a = *(const u32x4*)vp1, v1b = *(const u32x4*)(vp1 + 8);
    { u32x4 o0, o1; knorm16(k0a, k0b, P.k_slc_norm_w + part * 16, o0, o1); *(u32x4*)kp0 = o0; *(u32x4*)(kp0 + 8) = o1;
      knorm16(k1a, k1b, P.k_win_norm_w + part * 16, o0, o1); *(u32x4*)kp1 = o0; *(u32x4*)(kp1 + 8) = o1; }
    bf16_t* tile0 = (bf16_t*)smem; bf16_t* tile1 = tile0 + 64 * 130;
    LDS_BAR();
    { unsigned* tp = (unsigned*)(tile0 + tk * 130 + part * 16); const unsigned uw[8] = {v0a.x, v0a.y, v0a.z, v0a.w, v0b.x, v0b.y, v0b.z, v0b.w};
#pragma unroll
      for (int j = 0; j < 8; ++j) tp[j] = uw[j];
      unsigned* tq = (unsigned*)(tile1 + tk * 130 + part * 16); const unsigned ux[8] = {v1a.x, v1a.y, v1a.z, v1a.w, v1b.x, v1b.y, v1b.z, v1b.w};
#pragma unroll
      for (int j = 0; j < 8; ++j) tq[j] = ux[j]; }
    LDS_BAR();
    { const int d = tid >> 2, prt = tid & 3;
#pragma unroll
      for (int which = 0; which < 2; ++which) { const bf16_t* tile = which ? tile1 : tile0; unsigned w[8];
#pragma unroll
          for (int j = 0; j < 8; ++j) w[j] = (unsigned)tile[(prt * 16 + 2 * j) * 130 + d] | ((unsigned)tile[(prt * 16 + 2 * j + 1) * 130 + d] << 16);
          bf16_t* op = (which ? P_vwinT : P_vslcT) + ((size_t)(b * 2 + g) * 128 + d) * TT + t0 + prt * 16;
          *(u32x4*)op = (u32x4){w[0], w[1], w[2], w[3]}; *(u32x4*)(op + 8) = (u32x4){w[4], w[5], w[6], w[7]}; } }
    LDS_BAR();
}

DI void compress_item(const Params& P, unsigned char* smem, int item) {
    const int tid = opaque_tid(), lane = tid & 63, wave = tid >> 6, l32 = lane & 31, hh = lane >> 5;
    const int ct = item & 3, g = (item >> 2) & 1, b = (item >> 3) & 15, which = item >> 7;
    const int nt = wave & 3, kh = wave >> 2;
    const bf16_t* src = P_proj + (size_t)b * TT * LDP + (which ? C_VCMP : C_KCMP) + g * 128;
    const bf16_t* w1T = which ? P_w1vT : P_w1kT; const bf16_t* w2T = which ? P_w2vT : P_w2kT; const float* bias = which ? P_biasv : P_biask;
    float* red = (float*)smem;
    bf16_t* hid = (bf16_t*)(smem + 16384);
    float* outf = (float*)(smem + 32768);
    int crow_a = ct * 32 + l32; if (crow_a > 126) crow_a = 126;
    f32x16 acc;
#pragma unroll
    for (int i = 0; i < 16; ++i) acc[i] = 0.f;
#pragma unroll 4
    for (int l = 16 * kh; l < 16 * kh + 16; ++l) {
        const bf16_t* arow = src + (size_t)(16 * crow_a + l) * LDP; const bf16_t* brow = w1T + (size_t)(32 * nt + l32) * 4096 + l * 128;
#pragma unroll
        for (int ks = 0; ks < 8; ++ks) { const bf16x8 a = *(const bf16x8*)(arow + 16 * ks + 8 * hh), bb = *(const bf16x8*)(brow + 16 * ks + 8 * hh); acc = MFMA32(a, bb, acc); }
    }
    __syncthreads();
    if (kh == 1) {
#pragma unroll
        for (int i = 0; i < 16; ++i) red[(nt * 64 + lane) * 16 + i] = acc[i]; }
    __syncthreads();
    if (kh == 0) {
        const float bn = bias[32 * nt + l32];
#pragma unroll
        for (int i = 0; i < 16; ++i) { const float v = acc[i] + red[(nt * 64 + lane) * 16 + i] + bn; hid[crow(i, hh) * 136 + 32 * nt + l32] = f2bf(siluf_(v)); } }
    __syncthreads();
    if (kh == 0) {
        f32x16 o;
#pragma unroll
        for (int i = 0; i < 16; ++i) o[i] = 0.f;
#pragma unroll
        for (int ks = 0; ks < 8; ++ks) { const bf16x8 a = *(const bf16x8*)(hid + l32 * 136 + 16 * ks + 8 * hh), bb = *(const bf16x8*)(w2T + (size_t)(32 * nt + l32) * 128 + 16 * ks + 8 * hh); o = MFMA32(a, bb, o); }
#pragma unroll
        for (int i = 0; i < 16; ++i) outf[crow(i, hh) * 132 + 32 * nt + l32] = o[i];
    }
    __syncthreads();
    if (which == 0) {
        const int r = tid >> 4, part = tid & 15; float v[8]; float s = 0.f;
#pragma unroll
        for (int j = 0; j < 8; ++j) { v[j] = outf[r * 132 + part * 8 + j]; s += v[j] * v[j]; }
        s += __shfl_xor(s, 1); s += __shfl_xor(s, 2); s += __shfl_xor(s, 4); s += __shfl_xor(s, 8);
        const float rstd = 1.f / sqrtf(s * (1.f / 128.f) + EPSF); const float* nw = P.k_cmp_norm_w + part * 8;
        const int cidx = ct * 32 + r; u32x4 w = {0u, 0u, 0u, 0u};
        if (cidx < 127) { w.x = pk2(v[0] * rstd * nw[0], v[1] * rstd * nw[1]); w.y = pk2(v[2] * rstd * nw[2], v[3] * rstd * nw[3]); w.z = pk2(v[4] * rstd * nw[4], v[5] * rstd * nw[5]); w.w = pk2(v[6] * rstd * nw[6], v[7] * rstd * nw[7]); }
        *(u32x4*)(P_kc + ((size_t)(b * 2 + g) * 128 + cidx) * 128 + part * 8) = w;
    } else {
        const int d = tid >> 2, part = tid & 3; unsigned w[4];
#pragma unroll
        for (int j = 0; j < 4; ++j) { const int r0 = part * 8 + 2 * j; const float v0 = (ct * 32 + r0 < 127) ? outf[r0 * 132 + d] : 0.f, v1 = (ct * 32 + r0 + 1 < 127) ? outf[(r0 + 1) * 132 + d] : 0.f; w[j] = pk2(v0, v1); }
        *(u32x4*)(P_vcT + ((size_t)(b * 2 + g) * 128 + d) * 128 + ct * 32 + part * 8) = (u32x4){w[0], w[1], w[2], w[3]};
    }
    __syncthreads();
}

DI void phase_mix(const Params& P, unsigned char* smem) {
    constexpr int I_SSD = 256, I_KV = 1024, I_CMP = 256, I_WT = 3 * 1024;
    constexpr int NIT = I_SSD + I_KV + I_CMP + I_WT;
    for (int it = blockIdx.x; it < NIT; it += gridDim.x) {
        int r = it;
        if (r < I_SSD) { ssd_pair_item(P, smem, r >> 4, r & 15); __syncthreads(); continue; } r -= I_SSD;
        if (r < I_KV) { kvprep_item(P, smem, r); continue; } r -= I_KV;
        if (r < I_CMP) { compress_item(P, smem, r); continue; } r -= I_CMP;
        { const int m = r >> 10, t = r & 1023, kb = t & 31, nb = t >> 5; float* tile = (float*)smem;
          if (m == 0) transpose_tile(P.w_out_ssd, DM, P_wossdT, 4096, kb * 64, nb * 64, 0, P.ssd_norm_w, tile);
          else if (m == 1) transpose_tile(P.w_out_nsa, DM, P_wossdT + 2048, 4096, kb * 64, nb * 64, 0, nullptr, tile);
          else transpose_tile(P.w_o, DM, P_woT, DM, kb * 64, nb * 64, 0, nullptr, tile); }
    }
}

constexpr int NSA_WAVE_LDS = 16384, NSA_K_OFF = 0, NSA_V_OFF = 8192;
constexpr float SM_SCALE = 0.08838834764831845f * 1.4426950408889634f;

struct AttnState { f32x16 acc[4]; float m, l; };

DI void dma_k_tile(LAS unsigned char* wl, const bf16_t* krow0, unsigned kstride_b, int lane) {
    const int rr = lane >> 4, c0 = (lane & 15) ^ rr;
    const unsigned lo = (unsigned)rr * kstride_b;
#pragma unroll
    for (int j = 0; j < 8; ++j) { const unsigned voff = lo + (unsigned)((c0 ^ ((4 * j) & 15)) * 16); const char* ub = (const char*)krow0 + (size_t)(4 * j) * kstride_b;
        __builtin_amdgcn_global_load_lds((const unsigned*)(ub + voff), (LAS unsigned*)(wl + NSA_K_OFF + j * 1024), 16, 0, 0); }
}
DI void dma_v_tile(LAS unsigned char* wl, const bf16_t* vcol0, unsigned vtstride_b, int lane) {
    const int dr = lane >> 2, vpos = lane & 3;
    const unsigned voff = (unsigned)dr * vtstride_b + (unsigned)((vpos ^ ((dr >> 2) & 3)) * 16);
#pragma unroll
    for (int j = 0; j < 8; ++j) { const char* ub = (const char*)vcol0 + (size_t)(16 * j) * vtstride_b;
        __builtin_amdgcn_global_load_lds((const unsigned*)(ub + voff), (LAS unsigned*)(wl + NSA_V_OFF + j * 1024), 16, 0, 0); }
}
DI f32x16 qk_tile(LAS unsigned char* wl, const bf16x8 (&qf)[8], int lane) {
    const int l32 = lane & 31, hh = lane >> 5;
    f32x16 S;
#pragma unroll
    for (int i = 0; i < 16; ++i) S[i] = 0.f;
#pragma unroll
    for (int ks = 0; ks < 8; ++ks) { const bf16x8 a = *(const LAS bf16x8*)(wl + NSA_K_OFF + l32 * 256 + (((2 * ks + hh) ^ (l32 & 15)) * 16)); S = MFMA32(a, qf[ks], S); }
    return S;
}

template <int MODE>
DI void attn_tile(LAS unsigned char* wl, const bf16_t* kbase, unsigned kstride, const bf16_t* vtbase, unsigned vtstride, int key_base, const bf16x8 (&qf)[8],
                  AttnState& st, int tq, bool rowsel, int lane_in) {
    const int lane = opaque_i(lane_in);
    const int l32 = lane & 31, hh = lane >> 5;
    LDS_FENCE();
    dma_k_tile(wl, kbase + (size_t)key_base * kstride, kstride * 2u, lane);
    dma_v_tile(wl, vtbase + key_base, vtstride * 2u, lane);
    asm volatile("s_waitcnt vmcnt(8)" ::: "memory");
    f32x16 S = qk_tile(wl, qf, lane);
    float mx = -1e30f;
#pragma unroll
    for (int i = 0; i < 16; ++i) { const int pos = key_base + crow(i, hh); bool ok;
        if (MODE == 0) ok = (16 * pos + 31 <= tq); else if (MODE == 1) ok = rowsel && (pos <= tq); else ok = (pos <= tq) && (pos > tq - 512);
        const float xv = ok ? S[i] * SM_SCALE : -1e30f; S[i] = xv; mx = fmaxf(mx, xv); }
    mx = fmaxf(mx, __shfl_xor(mx, 32));
    const float mnew = fmaxf(st.m, mx), alpha = __builtin_amdgcn_exp2f(st.m - mnew); float ps = 0.f;
#pragma unroll
    for (int i = 0; i < 16; ++i) { const float p = (S[i] > -1e29f) ? __builtin_amdgcn_exp2f(S[i] - mnew) : 0.f; S[i] = p; ps += p; }
    ps += __shfl_xor(ps, 32);
    st.l = st.l * alpha + ps; st.m = mnew;
#pragma unroll
    for (int dt = 0; dt < 4; ++dt)
#pragma unroll
        for (int i = 0; i < 16; ++i) st.acc[dt][i] *= alpha;
    const bf16x8 p0 = pack8(S, 0), p1 = pack8(S, 1);
    asm volatile("s_waitcnt vmcnt(0)" ::: "memory");
#pragma unroll
    for (int dt = 0; dt < 4; ++dt) {
        const int d = 32 * dt + l32, sw = (d >> 2) & 3;
        LAS unsigned char* vp = wl + NSA_V_OFF + d * 64 + 8 * hh;
        const bf16x8 a0 = cat44(*(const LAS s16x4*)(vp + ((0 ^ sw) * 16)), *(const LAS s16x4*)(vp + ((1 ^ sw) * 16))), a1 = cat44(*(const LAS s16x4*)(vp + ((2 ^ sw) * 16)), *(const LAS s16x4*)(vp + ((3 ^ sw) * 16)));
        st.acc[dt] = MFMA32(a0, p0, st.acc[dt]); st.acc[dt] = MFMA32(a1, p1, st.acc[dt]);
    }
}

DI void attn_reset(AttnState& st) {
    st.m = -1e30f; st.l = 0.f;
#pragma unroll
    for (int dt = 0; dt < 4; ++dt)
#pragma unroll
        for (int i = 0; i < 16; ++i) st.acc[dt][i] = 0.f;
}

DI void nsa_item(const Params& P, LAS unsigned char* wl, int b, int g, int t0, int lane_in) {
    const int lane = opaque_i(lane_in);
    const int l32 = lane & 31, hh = lane >> 5; const int tki = l32 >> 3, head = g * 8 + (l32 & 7); const int tq = t0 + tki;
    const unsigned tok = (unsigned)(b * TT + tq); const unsigned poff = tok * (unsigned)LDP; const unsigned ooff = tok * 4096u + 2048u + (unsigned)head * 128u;
    bf16x8 qf[8];
    {
        float qv[64]; float s = 0.f;
#pragma unroll
        for (int ks = 0; ks < 8; ++ks) { const u32x4 a = *(const u32x4*)(P_proj + (poff + C_Q + head * 128 + 16 * ks + 8 * hh)); const unsigned uw[4] = {a.x, a.y, a.z, a.w};
#pragma unroll
            for (int j = 0; j < 4; ++j) { const float v0 = lo16(uw[j]), v1 = hi16(uw[j]); qv[8 * ks + 2 * j] = v0; qv[8 * ks + 2 * j + 1] = v1; s += v0 * v0 + v1 * v1; } }
        s += __shfl_xor(s, 32);
        const float rstd = 1.f / sqrtf(s * (1.f / 128.f) + EPSF);
#pragma unroll
        for (int ks = 0; ks < 8; ++ks) { const f32x4 w0 = *(const f32x4*)(P.q_norm_w + 16 * ks + 8 * hh), w1 = *(const f32x4*)(P.q_norm_w + 16 * ks + 8 * hh + 4);
            u32x4 o; o.x = pk2(qv[8 * ks + 0] * rstd * w0[0], qv[8 * ks + 1] * rstd * w0[1]); o.y = pk2(qv[8 * ks + 2] * rstd * w0[2], qv[8 * ks + 3] * rstd * w0[3]);
            o.z = pk2(qv[8 * ks + 4] * rstd * w1[0], qv[8 * ks + 5] * rstd * w1[1]); o.w = pk2(qv[8 * ks + 6] * rstd * w1[2], qv[8 * ks + 7] * rstd * w1[3]);
            qf[ks] = __builtin_bit_cast(bf16x8, o); }
    }
    AttnState st;
    const bf16_t* kcb = P_kc + (size_t)(b * 2 + g) * 128 * 128; const bf16_t* vcb = P_vcT + (size_t)(b * 2 + g) * 128 * 128;
    const int ncv = (t0 + 3 >= 31) ? ((t0 + 3 - 31) >> 4) + 1 : 0;
    const int nct = (ncv + 31) >> 5;
    attn_reset(st);
    for (int kt = 0; kt < nct; ++kt) attn_tile<0>(wl, kcb, 128, vcb, 128, kt * 32, qf, st, tq, true, lane);
    {
        const float g0 = sigmoidf_(bf2f(P_proj[poff + C_GATE + head * 3 + 0]));
        const float inv = st.l > 0.f ? g0 / st.l : 0.f;
#pragma unroll
        for (int dt = 0; dt < 4; ++dt)
#pragma unroll
            for (int ig = 0; ig < 4; ++ig) { const int d0 = 32 * dt + 8 * ig + 4 * hh;
                u32x2 w; w.x = pk2(st.acc[dt][4 * ig] * inv, st.acc[dt][4 * ig + 1] * inv); w.y = pk2(st.acc[dt][4 * ig + 2] * inv, st.acc[dt][4 * ig + 3] * inv);
                *(u32x2*)(P_onsa + (ooff + d0)) = w; }
    }
    LAS float* psum = (LAS float*)(wl + NSA_V_OFF); LAS float* vals = (LAS float*)(wl + NSA_V_OFF + 2048);
    {
        const float invl = st.l > 0.f ? 1.f / st.l : 0.f; const float mfin = st.m;
        asm volatile("" ::: "memory");
        for (int i = lane; i < 512; i += 64) psum[i] = 0.f;
        LDS_FENCE();
        for (int kt = 0; kt < nct; ++kt) {
            LDS_FENCE();
            dma_k_tile(wl, kcb + (size_t)kt * 32 * 128, 256u, lane);
            asm volatile("s_waitcnt vmcnt(0)" ::: "memory");
            f32x16 S = qk_tile(wl, qf, lane);
#pragma unroll
            for (int i = 0; i < 16; ++i) { const int cidx = kt * 32 + crow(i, hh); const bool ok = (16 * cidx + 31 <= tq);
                float p = ok ? __builtin_amdgcn_exp2f(S[i] * SM_SCALE - mfin) * invl : 0.f;
                p += __shfl_xor(p, 1); p += __shfl_xor(p, 2); p += __shfl_xor(p, 4);
                if ((lane & 7) == 0) psum[tki * 128 + cidx] = p; }
            LDS_FENCE();
        }
    }
    unsigned selm[4];
#pragma unroll
    for (int tt = 0; tt < 2; ++tt) {
        const int tkn = 2 * tt + hh, j = l32; const int tqq = t0 + tkn, cur = tqq >> 6;
        float imp = 0.f;
#pragma unroll
        for (int c = -1; c < 4; ++c) { const int ci = 4 * j + c; if (ci >= 0) imp += psum[tkn * 128 + ci]; }
        const bool forced = (j == cur) || (j == 0), validb = (j <= cur);
        const unsigned key = forced ? 0x7f000000u : (validb ? (__float_as_uint(fmaxf(imp, 0.f)) + 1u) : 0u);
        ((LAS unsigned*)vals)[tkn * 32 + j] = key;
        LDS_FENCE();
        const unsigned long long kk = ((unsigned long long)key << 5) | (unsigned)(31 - j);
        int rank = 0;
#pragma unroll 4
        for (int jj = 0; jj < 32; ++jj) { const unsigned long long ko = ((unsigned long long)((LAS unsigned*)vals)[tkn * 32 + jj] << 5) | (unsigned)(31 - jj); rank += (ko > kk) ? 1 : 0; }
        const unsigned long long bal = __ballot(rank < 8);
        selm[2 * tt] = (unsigned)bal; selm[2 * tt + 1] = (unsigned)(bal >> 32);
    }
    LDS_FENCE();
    const unsigned mysel = tki == 0 ? selm[0] : (tki == 1 ? selm[1] : (tki == 2 ? selm[2] : selm[3]));
    {
        const int curb = t0 >> 6; const unsigned validm = (curb >= 31) ? 0xffffffffu : ((2u << curb) - 1u);
        unsigned U = (selm[0] | selm[1] | selm[2] | selm[3]) & validm;
        const bf16_t* kb = P_proj + (size_t)b * TT * LDP + C_KSLC + g * 128; const bf16_t* vb = P_vslcT + (size_t)(b * 2 + g) * 128 * TT;
        attn_reset(st);
        while (U) {
            const int j = __builtin_ctz(U); U &= U - 1u; const bool rs = (mysel >> j) & 1u;
            attn_tile<1>(wl, kb, LDP, vb, TT, 64 * j, qf, st, tq, rs, lane);
            if (64 * j + 32 <= t0 + 3) attn_tile<1>(wl, kb, LDP, vb, TT, 64 * j + 32, qf, st, tq, rs, lane);
        }
        const float g1 = sigmoidf_(bf2f(P_proj[poff + C_GATE + head * 3 + 1]));
        const float inv = st.l > 0.f ? g1 / st.l : 0.f;
#pragma unroll
        for (int dt = 0; dt < 4; ++dt)
#pragma unroll
            for (int ig = 0; ig < 4; ++ig) { const int d0 = 32 * dt + 8 * ig + 4 * hh; u32x2* op = (u32x2*)(P_onsa + (ooff + d0)); const u32x2 pv = *op;
                u32x2 w; w.x = pk2(lo16(pv.x) + st.acc[dt][4 * ig] * inv, hi16(pv.x) + st.acc[dt][4 * ig + 1] * inv); w.y = pk2(lo16(pv.y) + st.acc[dt][4 * ig + 2] * inv, hi16(pv.y) + st.acc[dt][4 * ig + 3] * inv);
                *op = w; }
    }
    {
        const bf16_t* kb = P_proj + (size_t)b * TT * LDP + C_KWIN + g * 128; const bf16_t* vb = P_vwinT + (size_t)(b * 2 + g) * 128 * TT;
        int lo = t0 - 511; if (lo < 0) lo = 0; lo &= ~31;
        attn_reset(st);
        for (int kb0 = lo; kb0 <= t0 + 3; kb0 += 32) attn_tile<2>(wl, kb, LDP, vb, TT, kb0, qf, st, tq, true, lane);
        const float g2 = sigmoidf_(bf2f(P_proj[poff + C_GATE + head * 3 + 2]));
        const float inv = st.l > 0.f ? g2 / st.l : 0.f;
#pragma unroll
        for (int dt = 0; dt < 4; ++dt)
#pragma unroll
            for (int i = 0; i < 16; ++i) st.acc[dt][i] *= inv;
    }
#pragma unroll
    for (int dt = 0; dt < 4; ++dt)
#pragma unroll
        for (int ig = 0; ig < 4; ++ig) { const int d0 = 32 * dt + 8 * ig + 4 * hh;
            const u32x2 zz = *(const u32x2*)(P_proj + (poff + C_ZNSA + head * 128 + d0));
            const u32x2 pv = *(const u32x2*)(P_onsa + (ooff + d0));
            const float o0 = st.acc[dt][4 * ig + 0] + lo16(pv.x), o1 = st.acc[dt][4 * ig + 1] + hi16(pv.x), o2 = st.acc[dt][4 * ig + 2] + lo16(pv.y), o3 = st.acc[dt][4 * ig + 3] + hi16(pv.y);
            u32x2 w; w.x = pk2(o0 * siluf_(lo16(zz.x)), o1 * siluf_(hi16(zz.x))); w.y = pk2(o2 * siluf_(lo16(zz.y)), o3 * siluf_(hi16(zz.y)));
            *(u32x2*)(P_onsa + (ooff + d0)) = w; }
}

constexpr int CO_RING = 0, CO_TOT = 65536, CO_SCR = 131072, CO_LIST = 151552, CO_UW = 152576;

DI void co_issue(const Params& P, LAS unsigned char* ring, int slot, unsigned desc, int b, int g, int wave, int lane) {
    const int mode = (int)(desc >> 16), key_base = (int)(desc & 0xffffu);
    const bf16_t* kb; const bf16_t* vb; unsigned ks_b, vs_b;
    if (mode <= 1) { kb = P_kc + (size_t)(b * 2 + g) * 128 * 128; ks_b = 256u; vb = P_vcT + (size_t)(b * 2 + g) * 128 * 128; vs_b = 256u; }
    else if (mode == 2) { kb = P_proj + (size_t)b * TT * LDP + C_KWIN + g * 128; ks_b = LDP * 2u; vb = P_vwinT + (size_t)(b * 2 + g) * 128 * TT; vs_b = TT * 2u; }
    else { kb = P_proj + (size_t)b * TT * LDP + C_KSLC + g * 128; ks_b = LDP * 2u; vb = P_vslcT + (size_t)(b * 2 + g) * 128 * TT; vs_b = TT * 2u; }
    LAS unsigned char* st = ring + slot * 16384;
    { const int rr = lane >> 4, c0 = (lane & 15) ^ rr; const unsigned voff = (unsigned)rr * ks_b + (unsigned)((c0 ^ ((4 * wave) & 15)) * 16);
      const char* ub = (const char*)kb + (size_t)(key_base + 4 * wave) * ks_b;
      __builtin_amdgcn_global_load_lds((const unsigned*)(ub + voff), (LAS unsigned*)(st + wave * 1024), 16, 0, 0); }
    { const int dr = lane >> 2, vpos = lane & 3; const unsigned voff = (unsigned)dr * vs_b + (unsigned)((vpos ^ ((dr >> 2) & 3)) * 16);
      const char* ub = (const char*)vb + (size_t)(16 * wave) * vs_b + (size_t)key_base * 2;
      __builtin_amdgcn_global_load_lds((const unsigned*)(ub + voff), (LAS unsigned*)(st + 8192 + wave * 1024), 16, 0, 0); }
}

DI f32x16 co_qk(LAS unsigned char* st, const bf16x8 (&qf)[8], int ka) {
    f32x16 S0, S1;
#pragma unroll
    for (int i = 0; i < 16; ++i) { S0[i] = 0.f; S1[i] = 0.f; }
#pragma unroll
    for (int ks = 0; ks < 8; ks += 2) {
        const bf16x8 a0 = *(const LAS bf16x8*)(st + (ka ^ (32 * ks)));
        const bf16x8 a1 = *(const LAS bf16x8*)(st + (ka ^ (32 * ks + 32)));
        S0 = MFMA32(a0, qf[ks], S0); S1 = MFMA32(a1, qf[ks + 1], S1); }
#pragma unroll
    for (int i = 0; i < 16; ++i) S0[i] += S1[i];
    return S0;
}

template <int MODE, bool FULL>
DI void co_tile(LAS unsigned char* st, int key_base, const bf16x8 (&qf)[8], AttnState& as, int tq, bool rowsel, int ka_in, int vb_in, int hh) {
    const int ka = opaque_i(ka_in), vb = opaque_i(vb_in);
    f32x16 S = co_qk(st, qf, ka);
    if (!FULL) {
        const int base = key_base + 4 * hh;
        const int hi = (MODE == 0) ? (((tq - 31) >> 4) - base) : (tq - base);
        const int lo = hi - 512;
#pragma unroll
        for (int i = 0; i < 16; ++i) { const int c = (i & 3) + 8 * (i >> 2); bool ok = (c <= hi); if (MODE == 2) ok = ok && (c > lo); S[i] = ok ? S[i] : -1e30f; }
    }
    if (MODE == 1) {
#pragma unroll
        for (int i = 0; i < 16; ++i) S[i] = rowsel ? S[i] : -1e30f;
    }
    float mx = S[0];
#pragma unroll
    for (int i = 1; i < 16; ++i) mx = fmaxf(mx, S[i]);
    mx = xh_max(mx);
    const float mxs = mx * SM_SCALE; const bool need = mxs > as.m + 8.f;
    const float mnew = need ? mxs : as.m, muse = -fmaxf(mnew, -1e20f); float ps = 0.f;
#pragma unroll
    for (int i = 0; i < 16; ++i) { const float p = __builtin_amdgcn_exp2f(__builtin_fmaf(S[i], SM_SCALE, muse)); S[i] = p; ps += p; }
    ps = xh_sum(ps);
    if (__builtin_amdgcn_ballot_w64(need) != 0ull) {
        const float alpha = __builtin_amdgcn_exp2f(as.m - mnew);
        as.l *= alpha;
#pragma unroll
        for (int dt = 0; dt < 4; ++dt)
#pragma unroll
            for (int i = 0; i < 16; ++i) as.acc[dt][i] *= alpha;
    }
    as.l += ps; as.m = mnew;
    const bf16x8 p0 = pack8(S, 0), p1 = pack8(S, 1);
#pragma unroll
    for (int dt = 0; dt < 4; ++dt) {
        LAS unsigned char* vp = st + 2048 * dt;
        const bf16x8 a0 = cat44(*(const LAS s16x4*)(vp + (vb ^ 0)), *(const LAS s16x4*)(vp + (vb ^ 16))), a1 = cat44(*(const LAS s16x4*)(vp + (vb ^ 32)), *(const LAS s16x4*)(vp + (vb ^ 48)));
        as.acc[dt] = MFMA32(a0, p0, as.acc[dt]); as.acc[dt] = MFMA32(a1, p1, as.acc[dt]);
    }
}

DI f32x16 co_qk1(LAS unsigned char* st, const bf16x8 (&qf)[8], int ka_in) {
    const int ka = opaque_i(ka_in);
    f32x16 S;
#pragma unroll
    for (int i = 0; i < 16; ++i) S[i] = 0.f;
    __builtin_amdgcn_s_setprio(1);
#pragma unroll
    for (int ks = 0; ks < 8; ++ks) { const bf16x8 a = *(const LAS bf16x8*)(st + (ka ^ (32 * ks))); S = MFMA32(a, qf[ks], S); }
    __builtin_amdgcn_s_setprio(0);
    return S;
}
template <int MODE>
DI void co_finish(f32x16 S, LAS unsigned char* st, int key_base, AttnState& as, int tq, bool rowsel, int vb_in, int hh) {
    const int vb = opaque_i(vb_in);
    {
        const int base = key_base + 4 * hh;
        const int hi = (MODE == 0) ? (((tq - 31) >> 4) - base) : (tq - base);
        const int lo = hi - 512;
#pragma unroll
        for (int i = 0; i < 16; ++i) { const int c = (i & 3) + 8 * (i >> 2); bool ok = (c <= hi); if (MODE == 2) ok = ok && (c > lo); if (MODE == 1) ok = ok && rowsel; S[i] = ok ? S[i] : -1e30f; }
    }
    float mx = S[0];
#pragma unroll
    for (int i = 1; i < 16; ++i) mx = fmaxf(mx, S[i]);
    mx = xh_max(mx);
    const float mxs = mx * SM_SCALE; const bool need = mxs > as.m + 8.f;
    const float mnew = need ? mxs : as.m, muse = -fmaxf(mnew, -1e20f); float ps = 0.f;
#pragma unroll
    for (int i = 0; i < 16; ++i) { const float p = __builtin_amdgcn_exp2f(__builtin_fmaf(S[i], SM_SCALE, muse)); S[i] = p; ps += p; }
    ps = xh_sum(ps);
    if (__builtin_amdgcn_ballot_w64(need) != 0ull) {
        const float alpha = __builtin_amdgcn_exp2f(as.m - mnew);
        as.l *= alpha;
#pragma unroll
        for (int dt = 0; dt < 4; ++dt)
#pragma unroll
            for (int i = 0; i < 16; ++i) as.acc[dt][i] *= alpha;
    }
    as.l += ps; as.m = mnew;
    const bf16x8 p0 = pack8(S, 0), p1 = pack8(S, 1);
    __builtin_amdgcn_s_setprio(1);
#pragma unroll
    for (int dt = 0; dt < 4; ++dt) {
        LAS unsigned char* vp = st + 2048 * dt;
        const bf16x8 a0 = cat44(*(const LAS s16x4*)(vp + (vb ^ 0)), *(const LAS s16x4*)(vp + (vb ^ 16))), a1 = cat44(*(const LAS s16x4*)(vp + (vb ^ 32)), *(const LAS s16x4*)(vp + (vb ^ 48)));
        as.acc[dt] = MFMA32(a0, p0, as.acc[dt]); as.acc[dt] = MFMA32(a1, p1, as.acc[dt]);
    }
    __builtin_amdgcn_s_setprio(0);
}
#define CO_STEP2(list, n, i) do { \
    if ((n) - 1 - (i) >= 1) asm volatile("s_waitcnt vmcnt(2)" ::: "memory"); else asm volatile("s_waitcnt vmcnt(0)" ::: "memory"); \
    asm volatile("s_waitcnt lgkmcnt(0)" ::: "memory"); __builtin_amdgcn_s_barrier(); asm volatile("" ::: "memory"); \
    if ((i) + 2 < (n)) co_issue(P, ring, ((i) + 2) & 3, (list)[(i) + 2], b, g, wave, lane); } while (0)
#define CO_PIPE(MODE, REL, KB, RS) do { const bool rel_ = (REL); LAS unsigned char* sp_ = ring + (i & 3) * 16384; f32x16 Sn_; \
    if (rel_) Sn_ = co_qk1(sp_, qf, ka); \
    if (pend) co_finish<MODE>(Sp, pst, pkb, st, tq, prs, vb, hh); \
    pend = rel_; if (rel_) { Sp = Sn_; pst = sp_; pkb = (KB); prs = (RS); } } while (0)
#define CO_DRAIN(MODE) do { if (pend) { co_finish<MODE>(Sp, pst, pkb, st, tq, prs, vb, hh); pend = false; } } while (0)

#define CO_STEP(list, n, i) do { const int rem_ = (n) - 1 - (i); \
    if (rem_ >= 2) asm volatile("s_waitcnt vmcnt(4)" ::: "memory"); else if (rem_ == 1) asm volatile("s_waitcnt vmcnt(2)" ::: "memory"); else asm volatile("s_waitcnt vmcnt(0)" ::: "memory"); \
    asm volatile("s_waitcnt lgkmcnt(0)" ::: "memory"); __builtin_amdgcn_s_barrier(); asm volatile("" ::: "memory"); \
    if ((i) + 3 < (n)) co_issue(P, ring, ((i) + 3) & 3, (list)[(i) + 3], b, g, wave, lane); } while (0)
#define CO_BAR() do { asm volatile("s_waitcnt lgkmcnt(0)" ::: "memory"); __builtin_amdgcn_s_barrier(); asm volatile("" ::: "memory"); } while (0)

DI void nsa_block_item(const Params& P, unsigned char* smem_g, int b, int g, int tb, int tid_in) {
    LAS unsigned char* sm = (LAS unsigned char*)smem_g;
    const int tid = opaque_i(tid_in), lane = tid & 63, wave = __builtin_amdgcn_readfirstlane(tid >> 6);
    const int l32 = lane & 31, hh = lane >> 5; const int tki = l32 >> 3, head = g * 8 + (l32 & 7);
    const int t0b = tb * 32, t0 = t0b + 4 * wave, tq = t0 + tki;
    const unsigned tok = (unsigned)(b * TT + tq); const unsigned poff = tok * (unsigned)LDP; const unsigned ooff = tok * 4096u + 2048u + (unsigned)head * 128u;
    const int ka = l32 * 256 + 16 * (hh ^ (l32 & 15)), vb = 8192 + l32 * 64 + 8 * hh + 16 * ((l32 >> 2) & 3);
    LAS unsigned char* ring = sm + CO_RING; LAS u32x2* totw = (LAS u32x2*)(sm + CO_TOT + wave * 8192);
    LAS float* psum = (LAS float*)(sm + CO_SCR + wave * 2560); LAS unsigned* vals = (LAS unsigned*)(sm + CO_SCR + wave * 2560 + 2048);
    LAS unsigned* list1 = (LAS unsigned*)(sm + CO_LIST); LAS unsigned* list2 = list1 + 32; LAS unsigned* uw = (LAS unsigned*)(sm + CO_UW);
    bf16x8 qf[8];
    {
        float qv[64]; float s = 0.f;
#pragma unroll
        for (int ks = 0; ks < 8; ++ks) { const u32x4 a = *(const u32x4*)(P_proj + (poff + C_Q + head * 128 + 16 * ks + 8 * hh)); const unsigned uw4[4] = {a.x, a.y, a.z, a.w};
#pragma unroll
            for (int j = 0; j < 4; ++j) { const float v0 = lo16(uw4[j]), v1 = hi16(uw4[j]); qv[8 * ks + 2 * j] = v0; qv[8 * ks + 2 * j + 1] = v1; s += v0 * v0 + v1 * v1; } }
        s += __shfl_xor(s, 32);
        const float rstd = 1.f / sqrtf(s * (1.f / 128.f) + EPSF);
#pragma unroll
        for (int ks = 0; ks < 8; ++ks) { const f32x4 w0 = *(const f32x4*)(P.q_norm_w + 16 * ks + 8 * hh), w1 = *(const f32x4*)(P.q_norm_w + 16 * ks + 8 * hh + 4);
            u32x4 o; o.x = pk2(qv[8 * ks + 0] * rstd * w0[0], qv[8 * ks + 1] * rstd * w0[1]); o.y = pk2(qv[8 * ks + 2] * rstd * w0[2], qv[8 * ks + 3] * rstd * w0[3]);
            o.z = pk2(qv[8 * ks + 4] * rstd * w1[0], qv[8 * ks + 5] * rstd * w1[1]); o.w = pk2(qv[8 * ks + 6] * rstd * w1[2], qv[8 * ks + 7] * rstd * w1[3]);
            qf[ks] = __builtin_bit_cast(bf16x8, o); }
    }
    const float g0 = sigmoidf_(bf2f(P_proj[poff + C_GATE + head * 3 + 0])), g1 = sigmoidf_(bf2f(P_proj[poff + C_GATE + head * 3 + 1])), g2 = sigmoidf_(bf2f(P_proj[poff + C_GATE + head * 3 + 2]));
    const int nA = (((t0b >> 4) + 1) + 31) >> 5;
    int lo = t0b - 511; if (lo < 0) lo = 0; lo &= ~31;
    const int nD = ((t0b - lo) >> 5) + 1, n1 = 2 * nA + nD;
    asm volatile("s_waitcnt vmcnt(0)" ::: "memory");
    CO_BAR();
    if (tid < n1) { const unsigned d = tid < nA ? (unsigned)(tid * 32) : (tid < 2 * nA ? ((1u << 16) | (unsigned)((tid - nA) * 32)) : ((2u << 16) | (unsigned)(lo + (tid - 2 * nA) * 32))); list1[tid] = d; }
    CO_BAR();
    AttnState st;
    bool pend = false, prs = false; f32x16 Sp; int pkb = 0; LAS unsigned char* pst = ring;
#pragma unroll
    for (int i2 = 0; i2 < 16; ++i2) Sp[i2] = 0.f;
#pragma unroll
    for (int s = 0; s < 2; ++s) if (s < n1) co_issue(P, ring, s, list1[s], b, g, wave, lane);
    int i = 0;
    attn_reset(st);
    for (; i < nA; ++i) { CO_STEP2(list1, n1, i); const int kb_ = 32 * i; CO_PIPE(0, 16 * kb_ + 31 <= t0 + 3, kb_, true); }
    CO_DRAIN(0);
    {
        const float inv = st.l > 0.f ? g0 / st.l : 0.f;
#pragma unroll
        for (int dt = 0; dt < 4; ++dt)
#pragma unroll
            for (int ig = 0; ig < 4; ++ig) { u32x2 w; w.x = pk2(st.acc[dt][4 * ig] * inv, st.acc[dt][4 * ig + 1] * inv); w.y = pk2(st.acc[dt][4 * ig + 2] * inv, st.acc[dt][4 * ig + 3] * inv); totw[(dt * 4 + ig) * 64 + lane] = w; }
    }
    {
        const float invl = st.l > 0.f ? 1.f / st.l : 0.f; const float mfin = st.m;
        for (int k = lane; k < 512; k += 64) psum[k] = 0.f;
        for (; i < 2 * nA; ++i) {
            CO_STEP2(list1, n1, i); const int kb_ = 32 * (i - nA);
            if (16 * kb_ + 31 <= t0 + 3) {
                f32x16 S = co_qk(ring + (i & 3) * 16384, qf, ka);
#pragma unroll
                for (int r = 0; r < 16; ++r) { const int cidx = kb_ + crow(r, hh); const bool ok = (16 * cidx + 31 <= tq);
                    float p = ok ? __builtin_amdgcn_exp2f(S[r] * SM_SCALE - mfin) * invl : 0.f;
                    p += __shfl_xor(p, 1); p += __shfl_xor(p, 2); p += __shfl_xor(p, 4);
                    if ((lane & 7) == 0) psum[tki * 128 + cidx] = p; }
            }
        }
    }
    LDS_FENCE();
    unsigned selm[4];
#pragma unroll
    for (int tt = 0; tt < 2; ++tt) {
        const int tkn = 2 * tt + hh, j = l32; const int tqq = t0 + tkn, cur = tqq >> 6;
        float imp = 0.f;
#pragma unroll
        for (int c = -1; c < 4; ++c) { const int ci = 4 * j + c; if (ci >= 0) imp += psum[tkn * 128 + ci]; }
        const bool forced = (j == cur) || (j == 0), validb = (j <= cur);
        const unsigned key = forced ? 0x7f000000u : (validb ? (__float_as_uint(fmaxf(imp, 0.f)) + 1u) : 0u);
        vals[tkn * 32 + j] = key;
        LDS_FENCE();
        const unsigned long long kk = ((unsigned long long)key << 5) | (unsigned)(31 - j);
        int rank = 0;
#pragma unroll 4
        for (int jj = 0; jj < 32; ++jj) { const unsigned long long ko = ((unsigned long long)vals[tkn * 32 + jj] << 5) | (unsigned)(31 - jj); rank += (ko > kk) ? 1 : 0; }
        const unsigned long long bal = __ballot(rank < 8);
        selm[2 * tt] = (unsigned)bal; selm[2 * tt + 1] = (unsigned)(bal >> 32);
    }
    const unsigned mysel = tki == 0 ? selm[0] : (tki == 1 ? selm[1] : (tki == 2 ? selm[2] : selm[3]));
    const int curw = t0 >> 6; const unsigned validw = (curw >= 31) ? 0xffffffffu : ((2u << curw) - 1u);
    const unsigned Uw = (unsigned)__builtin_amdgcn_readfirstlane((int)((selm[0] | selm[1] | selm[2] | selm[3]) & validw));
    if (lane == 0) uw[wave] = Uw;
    attn_reset(st);
    for (; i < n1; ++i) { CO_STEP2(list1, n1, i); const int kb_ = lo + 32 * (i - 2 * nA); CO_PIPE(2, kb_ + 31 >= t0 - 511 && kb_ <= t0 + 3, kb_, true); }
    CO_DRAIN(2);
    {
        const float inv = st.l > 0.f ? g2 / st.l : 0.f;
#pragma unroll
        for (int dt = 0; dt < 4; ++dt)
#pragma unroll
            for (int ig = 0; ig < 4; ++ig) { const u32x2 pv = totw[(dt * 4 + ig) * 64 + lane];
                u32x2 w; w.x = pk2(lo16(pv.x) + st.acc[dt][4 * ig] * inv, hi16(pv.x) + st.acc[dt][4 * ig + 1] * inv); w.y = pk2(lo16(pv.y) + st.acc[dt][4 * ig + 2] * inv, hi16(pv.y) + st.acc[dt][4 * ig + 3] * inv);
                totw[(dt * 4 + ig) * 64 + lane] = w; }
    }
    CO_BAR();
    unsigned Ub = 0u;
#pragma unroll
    for (int w = 0; w < 8; ++w) Ub |= uw[w];
    Ub = (unsigned)__builtin_amdgcn_readfirstlane((int)Ub);
    const int curb = t0b >> 6; const bool last_single = ((t0b & 32) == 0);
    const int n2 = 2 * __builtin_popcount(Ub) - (last_single ? 1 : 0);
    if (tid < 32 && ((Ub >> tid) & 1u)) { const int pos = 2 * __builtin_popcount(Ub & ((1u << tid) - 1u)); list2[pos] = (3u << 16) | (unsigned)(64 * tid); if (!(tid == curb && last_single)) list2[pos + 1] = (3u << 16) | (unsigned)(64 * tid + 32); }
    CO_BAR();
#pragma unroll
    for (int s = 0; s < 2; ++s) if (s < n2) co_issue(P, ring, s, list2[s], b, g, wave, lane);
    attn_reset(st);
    for (i = 0; i < n2; ++i) {
        CO_STEP2(list2, n2, i); const int kb_ = (int)(list2[i] & 0xffffu); const int j = kb_ >> 6;
        CO_PIPE(1, ((Uw >> j) & 1u) && kb_ <= t0 + 3, kb_, (bool)((mysel >> j) & 1u));
    }
    CO_DRAIN(1);
    {
        const int lane2 = opaque_i(lane); const int hh = lane2 >> 5, head = g * 8 + (lane2 & 7); const unsigned tok = (unsigned)(b * TT + t0 + ((lane2 & 31) >> 3));
        const unsigned poff = tok * (unsigned)LDP, ooff = tok * 4096u + 2048u + (unsigned)head * 128u;
        const float inv = st.l > 0.f ? g1 / st.l : 0.f;
#pragma unroll
        for (int dt = 0; dt < 4; ++dt)
#pragma unroll
            for (int ig = 0; ig < 4; ++ig) { const int d0 = 32 * dt + 8 * ig + 4 * hh;
                const u32x2 zz = *(const u32x2*)(P_proj + (poff + C_ZNSA + head * 128 + d0)); const u32x2 pv = totw[(dt * 4 + ig) * 64 + lane];
                const float o0 = st.acc[dt][4 * ig + 0] * inv + lo16(pv.x), o1 = st.acc[dt][4 * ig + 1] * inv + hi16(pv.x), o2 = st.acc[dt][4 * ig + 2] * inv + lo16(pv.y), o3 = st.acc[dt][4 * ig + 3] * inv + hi16(pv.y);
                u32x2 w; w.x = pk2(o0 * siluf_(lo16(zz.x)), o1 * siluf_(hi16(zz.x))); w.y = pk2(o2 * siluf_(lo16(zz.y)), o3 * siluf_(hi16(zz.y)));
                *(u32x2*)(P_onsa + (ooff + d0)) = w; }
    }
}

#ifndef NSA_COOP
#define NSA_COOP 1
#endif
DI void phase_nsa(const Params& P, unsigned char* smem) {
    const int tid = opaque_tid(), lane = tid & 63, wave = __builtin_amdgcn_readfirstlane(tid >> 6);
    LAS unsigned char* wl = (LAS unsigned char*)smem + wave * NSA_WAVE_LDS;
    for (int tk = blockIdx.x * 512 + tid; tk < NTOK; tk += gridDim.x * 512) {
        const f32x4* pp = (const f32x4*)(P_part + (size_t)tk * 64); float s = 0.f;
#pragma unroll
        for (int j = 0; j < 16; ++j) { const f32x4 v = pp[j]; s += (v[0] + v[1]) + (v[2] + v[3]); }
        P_rstd[tk] = 1.f / sqrtf(s * (1.f / 2048.f) + EPSF);
    }
#if NSA_COOP
    __syncthreads();
    for (int id = blockIdx.x; id < 2048; id += gridDim.x) {
        const int bg = id & 31; int tb = id >> 5; if ((tb >> 3) & 1) tb = (tb & ~7) | (7 - (tb & 7));
        nsa_block_item(P, smem, bg >> 1, bg & 1, tb, tid);
    }
    (void)wl; (void)lane;
#else
    const int nw = gridDim.x * 8;
    for (int id = blockIdx.x * 8 + wave; id < 16384; id += nw) {
        const int bg = id & 31, t4 = id >> 5;
        nsa_item(P, wl, bg >> 1, bg & 1, t4 * 4, lane);
    }
#endif
}

#define XB_TMO      128
#define XB_XCNT(j)  (256  + 64 * (j))
#define XB_XSUB(j)  (1280 + 64 * (j))
#define XB_XGEN(j)  (2304 + 64 * (j))
#define XB_TOP      3328
#define XB_TOPGEN   3392
#define XCD_BAR_WORDS 3456
#define XB_SPIN_CAP (1u << 18)
DI unsigned xb_ld(unsigned* p)              { return __hip_atomic_load(p, __ATOMIC_RELAXED, __HIP_MEMORY_SCOPE_AGENT); }
DI unsigned xb_add(unsigned* p, unsigned v) { return __hip_atomic_fetch_add(p, v, __ATOMIC_RELAXED, __HIP_MEMORY_SCOPE_AGENT); }
DI unsigned xb_xcc_id() { return (unsigned)__builtin_amdgcn_s_getreg((3 << 11) | 20) & 0xFu; }
#define XB_SPIN(cond, bar) do { unsigned _sp = 0; while (cond) { __builtin_amdgcn_s_sleep(1); \
    if ((++_sp & 255u) == 0u) { if (xb_ld(&(bar)[XB_TMO])) break; if (_sp > XB_SPIN_CAP) { atomicAdd(&(bar)[XB_TMO], 1u); break; } } } } while (0)
struct XcdBarrier { unsigned* bar; unsigned x; volatile LAS unsigned* st; };
DI XcdBarrier xcd_barrier_post(unsigned* bar, volatile LAS unsigned* st) {
    XcdBarrier b; b.bar = bar; b.x = xb_xcc_id(); b.st = st;
    if (threadIdx.x == 0) (void)xb_add(&bar[XB_XCNT(b.x)], 1u);
    return b;
}
DI void xcd_barrier_complete(unsigned* bar, unsigned x, unsigned& nloc, unsigned& nx) {
    const unsigned G = gridDim.x * gridDim.y * gridDim.z;
    unsigned sum, cnt, mine, sp = 0u;
    for (;;) {
        sum = 0u; cnt = 0u; mine = 0u;
#pragma unroll
        for (unsigned j = 0; j < 16; ++j) { const unsigned c = xb_ld(&bar[XB_XCNT(j)]); sum += c; cnt += (c > 0u) ? 1u : 0u; mine = (j == x) ? c : mine; }
        if (sum == G) break;
        __builtin_amdgcn_s_sleep(1);
        if ((++sp & 255u) == 0u) { if (xb_ld(&bar[XB_TMO])) break; if (sp > XB_SPIN_CAP) { atomicAdd(&bar[XB_TMO], 1u); break; } }
    }
    nloc = mine > 0u ? mine : 1u; nx = cnt > 0u ? cnt : 1u;
}
DI void xcd_barrier(const XcdBarrier& b) {
    asm volatile("s_waitcnt vmcnt(0)" ::: "memory");
    __syncthreads();
    if (threadIdx.x == 0) {
        unsigned* bar = b.bar;
        __builtin_amdgcn_s_waitcnt(0);
        unsigned nloc = b.st[0], nx = b.st[1];
        if (nloc == 0u) { xcd_barrier_complete(bar, b.x, nloc, nx); b.st[0] = nloc; b.st[1] = nx; }
        const unsigned old = xb_add(&bar[XB_XSUB(b.x)], 1u);
        const unsigned gen = old / nloc;
        if (old + 1u == (gen + 1u) * nloc) {
            __builtin_amdgcn_fence(__ATOMIC_RELEASE, "agent");
            asm volatile("s_waitcnt vmcnt(0)" ::: "memory");
            const unsigned og = xb_add(&bar[XB_TOP], 1u);
            const unsigned tg = og / nx;
            if (og + 1u == (tg + 1u) * nx) xb_add(&bar[XB_TOPGEN], 1u);
            else XB_SPIN(xb_ld(&bar[XB_TOPGEN]) == tg, bar);
            __builtin_amdgcn_fence(__ATOMIC_ACQUIRE, "agent");
            xb_add(&bar[XB_XGEN(b.x)], 1u);
            asm volatile("s_waitcnt vmcnt(0)" ::: "memory");
        } else {
            XB_SPIN(xb_ld(&bar[XB_XGEN(b.x)]) == gen, bar);
            __builtin_amdgcn_fence(__ATOMIC_ACQUIRE, "agent");
            asm volatile("s_waitcnt vmcnt(0)" ::: "memory");
        }
    }
    __syncthreads();
}

template <int PH>
DI void run_phase(const Params& P, unsigned char* smem) {
    pg8::StaticOrder S;
    if constexpr (PH == 0) phase_prep(P, smem);
    else if constexpr (PH == 1) { pg8::Gemm gm{P_h, P_winT, NTOK, LDP, DM, DM, DM}; S.init(NTOK, LDP, gridDim.x, blockIdx.x); pg8::EpiProj E{P_proj, LDP}; pg8::gemm_phase((LAS unsigned char*)smem, gm, S, E); }
    else if constexpr (PH == 2) phase_mix(P, smem);
    else if constexpr (PH == 3) phase_nsa(P, smem);
    else if constexpr (PH == 4) {
        S.init(NTOK, DM, gridDim.x, blockIdx.x);
        pg8::Gemm gm{P_yg, P_wossdT, NTOK, DM, 4096, 4096, 4096}; pg8::EpiMergeF E{P_proj, P_rstd}; pg8::gemm_phase((LAS unsigned char*)smem, gm, S, E);
    }
    else if constexpr (PH == 6) phase_bcconv(P);
    else if constexpr (PH == 5) { pg8::Gemm gm{P_proj, P_woT, NTOK, DM, DM, LDP, DM}; S.init(NTOK, DM, gridDim.x, blockIdx.x); pg8::EpiOut E{P.out, P.x}; pg8::gemm_phase((LAS unsigned char*)smem, gm, S, E); }
}

template <int LO, int HI>
__global__ void __launch_bounds__(512) fwd_kernel(Params P) {
    extern __shared__ __attribute__((aligned(16))) unsigned char smem[];
    if constexpr (HI - LO > 1) {
        cg::grid_group grid = cg::this_grid();
        if (P.ws == nullptr) grid.sync();
        volatile LAS unsigned* xst = (volatile LAS unsigned*)((LAS unsigned char*)smem + (LDS_BYTES - 16));
        if (threadIdx.x == 0) { xst[0] = 0u; xst[1] = 0u; }
        __syncthreads();
        const XcdBarrier xb = xcd_barrier_post((unsigned*)(P.ws + WS_BAR), xst);
        run_phase<0>(P, smem); xcd_barrier(xb);
        run_phase<1>(P, smem); xcd_barrier(xb);
        run_phase<6>(P, smem); xcd_barrier(xb);
        run_phase<2>(P, smem); xcd_barrier(xb);
        run_phase<3>(P, smem); xcd_barrier(xb);
        run_phase<4>(P, smem); xcd_barrier(xb);
        run_phase<5>(P, smem);
    } else {
        run_phase<LO>(P, smem);
    }
}

template <class K> static int setup_kernel(K kern) {
    if (hipFuncSetAttribute((const void*)kern, hipFuncAttributeMaxDynamicSharedMemorySize, LDS_BYTES) != hipSuccess) { fprintf(stderr, "kernel_launch: hipFuncSetAttribute failed\n"); return -1; }
    return 0;
}

extern "C" void kernel_launch(void* const* d_in, const int* in_sizes, int n_in, void* d_out, int out_size, void* d_ws, size_t ws_size, hipStream_t stream) {
    static int grid = 0;
    if (grid == 0) {
        if (n_in != 24 || in_sizes[0] != NTOK * DM || out_size != NTOK * DM || ws_size < WS_END) {
            fprintf(stderr, "kernel_launch: unexpected shapes / workspace (n_in %d, ws %zu, need %zu); nothing launched\n", n_in, ws_size, (size_t)WS_END); grid = -1; return; }
        int dev = 0, cus = 0, per_cu = 0;
        (void)hipGetDevice(&dev); (void)hipDeviceGetAttribute(&cus, hipDeviceAttributeMultiprocessorCount, dev);
#if ONE_LAUNCH
        if (setup_kernel(fwd_kernel<0, 6>)) { grid = -1; return; }
        (void)hipOccupancyMaxActiveBlocksPerMultiprocessor(&per_cu, (const void*)fwd_kernel<0, 6>, 512, LDS_BYTES);
        if (per_cu < 1) fprintf(stderr, "kernel_launch: occupancy query says %d blocks per CU\n", per_cu);
#else
        if (setup_kernel(fwd_kernel<0, 1>) || setup_kernel(fwd_kernel<1, 2>) || setup_kernel(fwd_kernel<2, 3>) || setup_kernel(fwd_kernel<3, 4>) || setup_kernel(fwd_kernel<4, 5>) || setup_kernel(fwd_kernel<5, 6>)) { grid = -1; return; }
#endif
        (void)hipGetLastError();
        grid = cus * 1;
    }
    if (grid < 0) return;
    Params p{};
    const float** fp = (const float**)&p;
    for (int i = 0; i < 24; ++i) fp[i] = (const float*)d_in[i];
    p.out = (float*)d_out; p.ws = (unsigned char*)d_ws;
#if ONE_LAUNCH
    if (hipMemsetAsync((unsigned char*)d_ws + WS_BAR, 0, XCD_BAR_WORDS * 4, stream) != hipSuccess) { fprintf(stderr, "kernel_launch: hipMemsetAsync failed\n"); return; }
    void* args[] = {&p};
    hipError_t e = hipLaunchCooperativeKernel((const void*)fwd_kernel<0, 6>, dim3(grid), dim3(512), args, LDS_BYTES, stream);
    if (e != hipSuccess) fprintf(stderr, "cooperative launch failed: %s (grid %d)\n", hipGetErrorString(e), grid);
#else
    hipLaunchKernelGGL((fwd_kernel<0, 1>), dim3(grid), dim3(512), LDS_BYTES, stream, p);
    hipLaunchKernelGGL((fwd_kernel<1, 2>), dim3(grid), dim3(512), LDS_BYTES, stream, p);
    hipLaunchKernelGGL((fwd_kernel<2, 3>), dim3(grid), dim3(512), LDS_BYTES, stream, p);
    hipLaunchKernelGGL((fwd_kernel<3, 4>), dim3(grid), dim3(512), LDS_BYTES, stream, p);
    hipLaunchKernelGGL((fwd_kernel<4, 5>), dim3(grid), dim3(512), LDS_BYTES, stream, p);
    hipLaunchKernelGGL((fwd_kernel<5, 6>), dim3(grid), dim3(512), LDS_BYTES, stream, p);
#endif
}
```

```cpp
#include <hip/hip_runtime.h>
#include <hip/hip_cooperative_groups.h>
#include <cstdio>
namespace cg = cooperative_groups;

#ifndef PROBE_DUP
#define PROBE_DUP -1
#endif
#ifndef ONE_LAUNCH
#define ONE_LAUNCH 1
#endif

#define DI __device__ __forceinline__
#define LAS __attribute__((address_space(3)))
typedef unsigned short bf16_t;
typedef short bf16x8 __attribute__((ext_vector_type(8)));
typedef short s16x4 __attribute__((ext_vector_type(4)));
typedef float f32x4 __attribute__((ext_vector_type(4)));
typedef float f32x2 __attribute__((ext_vector_type(2)));
typedef float f32x16 __attribute__((ext_vector_type(16)));
typedef unsigned u32x4 __attribute__((ext_vector_type(4)));
typedef unsigned u32x2 __attribute__((ext_vector_type(2)));
typedef __bf16 bf16x2_t __attribute__((ext_vector_type(2)));

constexpr int NTOK = 32768, TT = 2048, DM = 2048, LDP = 15104, INDIM = 14928;
constexpr int C_Z = 0, C_X = 2048, C_BM = 4096, C_CM = 4608, C_Q = 5120, C_KCMP = 7168, C_VCMP = 7424, C_KSLC = 7680, C_VSLC = 7936,
              C_KWIN = 8192, C_VWIN = 8448, C_ZNSA = 8704, C_GLS = 10752, C_GLN = 12800, C_DT = 14848, C_GATE = 14880;
constexpr float EPSF = 1e-6f;
constexpr int LDS_BYTES = 160 * 1024;

constexpr size_t WS_PROJ = 0, SZ_PROJ = (size_t)NTOK * LDP * 2;
constexpr size_t WS_WINT = WS_PROJ + SZ_PROJ, SZ_WINT = (size_t)LDP * DM * 2;
constexpr size_t WS_WOSSD = WS_WINT, WS_WONSA = WS_WINT + 8388608, WS_WO = WS_WINT + 16777216, WS_VSLCT = WS_WINT + 25165824, WS_VWINT = WS_WINT + 41943040;
constexpr size_t WS_SPARE = WS_WINT + SZ_WINT;
constexpr size_t WS_W1KT = WS_SPARE, WS_W1VT = WS_SPARE + 1048576, WS_W2KT = WS_SPARE + 2097152, WS_W2VT = WS_SPARE + 2129920,
                 WS_BIASK = WS_SPARE + 2162688, WS_BIASV = WS_SPARE + 2166784, WS_KC = WS_SPARE + 2170880, WS_VCT = WS_SPARE + 3219456,
                 WS_PART = WS_SPARE + 4268032, WS_RSTD = WS_SPARE + 12656640, WS_BAR = WS_SPARE + 12787712, WS_END = WS_BAR + 16384;

struct ParamsK {
    const float *x, *norm_w, *w_in, *conv_w, *conv_b, *dt_bias, *a_log, *d_skip, *ssd_norm_w, *q_norm_w, *k_cmp_norm_w, *k_slc_norm_w, *k_win_norm_w,
        *cmp_pe_k, *cmp_w1_k, *cmp_b1_k, *cmp_w2_k, *cmp_pe_v, *cmp_w1_v, *cmp_b1_v, *cmp_w2_v, *w_out_ssd, *w_out_nsa, *w_o;
    float* out; unsigned char* ws;
};
#define WSP(T, off) ((T*)(P.ws + (off)))
#define P_proj   WSP(bf16_t, WS_PROJ)
#define P_winT   WSP(bf16_t, WS_WINT)
#define P_h      ((bf16_t*)P.out)
#define P_yg     ((bf16_t*)P.out)
#define P_onsa   ((bf16_t*)P.out)
#define P_wossdT WSP(bf16_t, WS_WOSSD)
#define P_wonsaT WSP(bf16_t, WS_WONSA)
#define P_woT    WSP(bf16_t, WS_WO)
#define P_vslcT  WSP(bf16_t, WS_VSLCT)
#define P_vwinT  WSP(bf16_t, WS_VWINT)
#define P_kc     WSP(bf16_t, WS_KC)
#define P_vcT    WSP(bf16_t, WS_VCT)
#define P_w1kT   WSP(bf16_t, WS_W1KT)
#define P_w1vT   WSP(bf16_t, WS_W1VT)
#define P_w2kT   WSP(bf16_t, WS_W2KT)
#define P_w2vT   WSP(bf16_t, WS_W2VT)
#define P_biask  WSP(float, WS_BIASK)
#define P_biasv  WSP(float, WS_BIASV)
#define P_part   WSP(float, WS_PART)
#define P_rstd   WSP(float, WS_RSTD)
typedef ParamsK Params;

DI float bf2f(bf16_t u) { return __uint_as_float(((unsigned)u) << 16); }
DI unsigned pk2(float lo, float hi) { f32x2 v = {lo, hi}; bf16x2_t b = __builtin_convertvector(v, bf16x2_t); return __builtin_bit_cast(unsigned, b); }
DI bf16_t f2bf(float f) { return (bf16_t)(pk2(f, 0.f) & 0xffffu); }
DI float lo16(unsigned u) { return __uint_as_float(u << 16); }
DI float hi16(unsigned u) { return __uint_as_float(u & 0xffff0000u); }
DI float sigmoidf_(float x) { return __builtin_amdgcn_rcpf(1.f + __expf(-x)); }
DI float siluf_(float x) { return x * __builtin_amdgcn_rcpf(1.f + __expf(-x)); }
DI float wave_sum(float v) {
#pragma unroll
    for (int o = 1; o < 64; o <<= 1) v += __shfl_xor(v, o);
    return v;
}
DI int opaque_tid() { int t = threadIdx.x; asm volatile("" : "+v"(t)); return t; }
DI int opaque_i(int v) { asm volatile("" : "+v"(v)); return v; }
DI float xh_max(float x) { const unsigned u = __float_as_uint(x); const auto r = __builtin_amdgcn_permlane32_swap(u, u, false, false); return fmaxf(__uint_as_float(r[0]), __uint_as_float(r[1])); }
DI float xh_sum(float x) { const unsigned u = __float_as_uint(x); const auto r = __builtin_amdgcn_permlane32_swap(u, u, false, false); return __uint_as_float(r[0]) + __uint_as_float(r[1]); }
DI int crow(int i, int h) { return (i & 3) + 8 * (i >> 2) + 4 * h; }
#define MFMA32(a, b, c) __builtin_amdgcn_mfma_f32_32x32x16_bf16((a), (b), (c), 0, 0, 0)
DI bf16x8 pack8(const f32x16& x, int s) {
    u32x4 p;
    p.x = pk2(x[8 * s + 0], x[8 * s + 1]); p.y = pk2(x[8 * s + 2], x[8 * s + 3]); p.z = pk2(x[8 * s + 4], x[8 * s + 5]); p.w = pk2(x[8 * s + 6], x[8 * s + 7]);
    return __builtin_bit_cast(bf16x8, p);
}
DI bf16x8 cat44(s16x4 a, s16x4 b) { return __builtin_shufflevector(a, b, 0, 1, 2, 3, 4, 5, 6, 7); }
#define LDS_FENCE() asm volatile("s_waitcnt lgkmcnt(0)" ::: "memory")
#define LDS_BAR() do { asm volatile("s_waitcnt lgkmcnt(0)" ::: "memory"); __builtin_amdgcn_s_barrier(); asm volatile("" ::: "memory"); } while (0)

namespace pg8 {
constexpr int BM = 256, BK = 64, HALF = 128, HTB = HALF * BK * 2, STAGE_BYTES = 8 * HTB, NXCD = 8, WGM = 8;
DI int lds_byte(int r, int c) { const int st = (r >> 4) * 2 + (c >> 5), rr = r & 15, cc = c & 31, ob = rr * 64 + cc * 2; return st * 1024 + (ob ^ (((ob >> 9) & 1) << 5)); }
DI void stage_rc(int b, int& R, int& C) { const int st = b / 1024, sb = b % 1024, swz = sb ^ (((sb >> 9) & 1) << 5); R = (st >> 1) * 16 + swz / 64; C = (st & 1) * 32 + (swz % 64) / 2; }
DI int perm32(int rho) { const int n = rho >> 4, i = rho & 15; return 8 * (i >> 2) + 4 * n + (i & 3); }
struct Unit { int pm, pn; };
struct Gemm { const bf16_t* A; const bf16_t* Bt; int M, N, K, lda, ldb; };
struct StaticOrder {
    int nM, nN, nwg, G, c;
    DI void init(int M, int N, int G_, int c_) { nM = M / BM; nN = N / BM; nwg = nM * nN; G = G_; c = c_; }
    DI bool next(int i, Unit& u) const {
        const long L = (long)i * G + c; if (L >= nwg) return false;
        int wgid = (int)L; { const int q = nwg / NXCD, r = nwg % NXCD, xcd = wgid % NXCD, off = wgid / NXCD; wgid = (xcd < r ? xcd * (q + 1) : r * (q + 1) + (xcd - r) * q) + off; }
        const int nig = WGM * nN, gid = wgid / nig, fm = gid * WGM, gsz = (nM - fm) < WGM ? (nM - fm) : WGM;
        u.pm = fm + ((wgid % nig) % gsz); u.pn = (wgid % nig) / gsz; return true;
    }
};

template <class Epi>
DI void gemm_phase(LAS unsigned char* lds, const Gemm g, const StaticOrder& S, const Epi& E) {
    const int tid = opaque_tid(), wid = __builtin_amdgcn_readfirstlane(tid >> 6), lane = tid & 63, wr = wid >> 2, wc = wid & 3, fr = lane & 15, fq = lane >> 4;
    const int K = g.K, nt = K / BK;
    unsigned voffA[2], voffB[2];
#pragma unroll
    for (int i = 0; i < 2; ++i) { int R, C; stage_rc(tid * 16 + i * 8192, R, C); const int Rb = Epi::PERM ? ((R & ~31) + perm32(R & 31)) : R;
        voffA[i] = (unsigned)(R * g.lda + C) * 2u; voffB[i] = (unsigned)(Rb * g.ldb + C) * 2u; }
    const size_t kstep = (size_t)(BK * 2);
    const size_t hstepA = (size_t)HALF * g.lda * 2, hstepB = (size_t)HALF * g.ldb * 2;
    const size_t tstepA = 2 * hstepA, tstepB = 2 * hstepB;
    const unsigned ldsw = (unsigned)wid * 1024u;
    const int aoff = lds_byte(wr * 64 + fr, fq * 8), boff = lds_byte(wc * 32 + fr, fq * 8);
#define PG8_SA(b, h) (((b) * 2 + (h)) * HTB)
#define PG8_SB(b, h) ((4 + (b) * 2 + (h)) * HTB)
#define PG8_STAGE(bufoff, gbase, voff) do { _Pragma("unroll") for (int _i = 0; _i < 2; ++_i) \
        __builtin_amdgcn_global_load_lds((const unsigned*)((const char*)(gbase) + (voff)[_i]), (LAS unsigned*)(lds + (bufoff) + ldsw + _i * 8192), 16, 0, 0); } while (0)
#define PG8_LDA(dst, b, h) do { _Pragma("unroll") for (int m = 0; m < 4; ++m) _Pragma("unroll") for (int k = 0; k < 2; ++k) dst[m][k] = *(const LAS bf16x8*)(lds + PG8_SA(b, h) + aoff + m * 2048 + k * 1024); } while (0)
#define PG8_LDB(dst, b, h) do { _Pragma("unroll") for (int n = 0; n < 2; ++n) _Pragma("unroll") for (int k = 0; k < 2; ++k) dst[n][k] = *(const LAS bf16x8*)(lds + PG8_SB(b, h) + boff + n * 2048 + k * 1024); } while (0)
#define PG8_MMA(ai, bj, At, Bt) do { __builtin_amdgcn_s_setprio(1); _Pragma("unroll") for (int m = 0; m < 4; ++m) _Pragma("unroll") for (int n = 0; n < 2; ++n) _Pragma("unroll") for (int k = 0; k < 2; ++k) \
        acc[ai][bj][m][n] = __builtin_amdgcn_mfma_f32_16x16x32_bf16(Bt[n][k], At[m][k], acc[ai][bj][m][n], 0, 0, 0); __builtin_amdgcn_s_setprio(0); } while (0)
#define PG8_WAIT_V(n) asm volatile("s_waitcnt vmcnt(" #n ")" ::: "memory")
#define PG8_WAIT_L(n) asm volatile("s_waitcnt lgkmcnt(" #n ")" ::: "memory")
#define PG8_BAR __builtin_amdgcn_s_barrier()
#define PG8_SCHED __builtin_amdgcn_sched_barrier(0)
    Unit cur, nxt; int ui = 0;
    if (!S.next(0, cur)) return;
    f32x4 acc[2][2][4][2];
#pragma unroll
    for (int a = 0; a < 2; ++a)
#pragma unroll
        for (int b = 0; b < 2; ++b)
#pragma unroll
            for (int m = 0; m < 4; ++m)
#pragma unroll
                for (int n = 0; n < 2; ++n) acc[a][b][m][n] = (f32x4){0.f, 0.f, 0.f, 0.f};
    bf16x8 At[4][2], B0[2][2], B1[2][2];
    const char* cA = (const char*)g.A + (size_t)cur.pm * tstepA; const char* cB = (const char*)g.Bt + (size_t)cur.pn * tstepB;
    PG8_STAGE(PG8_SB(0, 0), cB, voffB); PG8_STAGE(PG8_SA(0, 0), cA, voffA); PG8_STAGE(PG8_SB(0, 1), cB + hstepB, voffB); PG8_STAGE(PG8_SA(0, 1), cA + hstepA, voffA);
    if (wr == 1) PG8_BAR;
    PG8_WAIT_V(4); PG8_BAR;
    PG8_STAGE(PG8_SB(1, 0), cB + kstep, voffB); PG8_STAGE(PG8_SA(1, 0), cA + kstep, voffA); PG8_STAGE(PG8_SB(1, 1), cB + hstepB + kstep, voffB);
    PG8_WAIT_V(6); PG8_BAR;
    for (;;) {
        const bool has_next = S.next(ui + 1, nxt);
        const char* nA = has_next ? (const char*)g.A + (size_t)nxt.pm * tstepA : cA; const char* nB = has_next ? (const char*)g.Bt + (size_t)nxt.pn * tstepB : cB;
        for (int t = 0; t < nt; t += 2) {
            const bool last = (t == nt - 2);
            const char* a1 = cA + (size_t)(t + 1) * kstep;
            const char* a2 = last ? nA : cA + (size_t)(t + 2) * kstep; const char* b2 = last ? nB : cB + (size_t)(t + 2) * kstep;
            const char* a3 = a2 + kstep; const char* b3 = b2 + kstep;
            if constexpr (Epi::HAS_MID) { if (t == Epi::MID_T) E.mid(acc, cur, wr, wc, fr, fq); }
            PG8_LDB(B0, 0, 0); PG8_SCHED; PG8_LDA(At, 0, 0); PG8_STAGE(PG8_SA(1, 1), a1 + hstepA, voffA);
            PG8_WAIT_L(8); PG8_BAR; PG8_WAIT_L(0); PG8_MMA(0, 0, At, B0); PG8_BAR; PG8_SCHED;
            PG8_LDB(B1, 0, 1); PG8_STAGE(PG8_SB(0, 0), b2, voffB);
            PG8_BAR; PG8_WAIT_L(0); PG8_MMA(0, 1, At, B1); PG8_BAR;
            PG8_LDA(At, 0, 1); PG8_STAGE(PG8_SA(0, 0), a2, voffA);
            PG8_BAR; PG8_WAIT_L(0); PG8_MMA(1, 0, At, B0); PG8_BAR; PG8_SCHED;
            PG8_STAGE(PG8_SB(0, 1), b2 + hstepB, voffB);
            PG8_WAIT_V(6); PG8_BAR; PG8_MMA(1, 1, At, B1); PG8_BAR;
            PG8_LDB(B0, 1, 0); PG8_SCHED; PG8_LDA(At, 1, 0); PG8_STAGE(PG8_SA(0, 1), a2 + hstepA, voffA);
            PG8_WAIT_L(8); PG8_BAR; PG8_WAIT_L(0); PG8_MMA(0, 0, At, B0); PG8_BAR; PG8_SCHED;
            PG8_LDB(B1, 1, 1); PG8_STAGE(PG8_SB(1, 0), b3, voffB);
            PG8_BAR; PG8_WAIT_L(0); PG8_MMA(0, 1, At, B1); PG8_BAR;
            PG8_LDA(At, 1, 1); PG8_STAGE(PG8_SA(1, 0), a3, voffA);
            PG8_BAR; PG8_WAIT_L(0); PG8_MMA(1, 0, At, B0); PG8_BAR; PG8_SCHED;
            PG8_STAGE(PG8_SB(1, 1), b3 + hstepB, voffB);
            PG8_WAIT_V(6); PG8_BAR; PG8_MMA(1, 1, At, B1); PG8_BAR;
        }
        E(acc, cur, wr, wc, fr, fq);
        if (!has_next) break;
#pragma unroll
        for (int a = 0; a < 2; ++a)
#pragma unroll
            for (int b = 0; b < 2; ++b)
#pragma unroll
                for (int m = 0; m < 4; ++m)
#pragma unroll
                    for (int n = 0; n < 2; ++n) acc[a][b][m][n] = (f32x4){0.f, 0.f, 0.f, 0.f};
        cur = nxt; cA = nA; cB = nB; ++ui;
    }
    PG8_WAIT_V(0);
    if (wr == 0) PG8_BAR;
    PG8_BAR;
#undef PG8_SA
#undef PG8_SB
#undef PG8_STAGE
#undef PG8_LDA
#undef PG8_LDB
#undef PG8_MMA
#undef PG8_WAIT_V
#undef PG8_WAIT_L
#undef PG8_BAR
#undef PG8_SCHED
}

struct EpiProj {
    static constexpr bool PERM = true, HAS_MID = false; static constexpr int MID_T = -1;
    bf16_t* O; int ldc;
    DI void operator()(const f32x4 (&acc)[2][2][4][2], const Unit& u, int wr, int wc, int fr, int fq) const {
        const int row0 = u.pm * BM + wr * 64 + fr, col0 = u.pn * BM + wc * 32 + 8 * fq;
#pragma unroll
        for (int ai = 0; ai < 2; ++ai)
#pragma unroll
            for (int m = 0; m < 4; ++m) { bf16_t* rowp = O + (size_t)(row0 + ai * HALF + m * 16) * ldc + col0;
#pragma unroll
                for (int bj = 0; bj < 2; ++bj) { const f32x4 v0 = acc[ai][bj][m][0], v1 = acc[ai][bj][m][1];
                    u32x4 w; w.x = pk2(v0[0], v0[1]); w.y = pk2(v0[2], v0[3]); w.z = pk2(v1[0], v1[1]); w.w = pk2(v1[2], v1[3]);
                    *(u32x4*)(rowp + bj * HALF) = w; } }
    }
};
template <int MODE>
struct EpiMerge {
    static constexpr bool PERM = true, HAS_MID = false; static constexpr int MID_T = -1;
    bf16_t* P; const float* rstd;
    DI void operator()(const f32x4 (&acc)[2][2][4][2], const Unit& u, int wr, int wc, int fr, int fq) const {
        const int row0 = u.pm * BM + wr * 64 + fr, col0 = u.pn * BM + wc * 32 + 8 * fq;
#pragma unroll
        for (int ai = 0; ai < 2; ++ai)
#pragma unroll
            for (int m = 0; m < 4; ++m) { const int row = row0 + ai * HALF + m * 16; bf16_t* rowp = P + (size_t)row * LDP + col0;
                const float rs = (MODE == 0) ? rstd[row] : 1.f;
#pragma unroll
                for (int bj = 0; bj < 2; ++bj) { const f32x4 v0 = acc[ai][bj][m][0], v1 = acc[ai][bj][m][1];
                    const u32x4 gl = *(const u32x4*)(rowp + bj * HALF + (MODE == 0 ? C_GLS : C_GLN));
                    float o[8] = {v0[0], v0[1], v0[2], v0[3], v1[0], v1[1], v1[2], v1[3]};
                    const unsigned gw[4] = {gl.x, gl.y, gl.z, gl.w};
                    u32x4 prev = {0u, 0u, 0u, 0u};
                    if (MODE == 1) prev = *(const u32x4*)(rowp + bj * HALF);
                    const unsigned pw[4] = {prev.x, prev.y, prev.z, prev.w};
#pragma unroll
                    for (int j = 0; j < 4; ++j) {
                        o[2 * j] = o[2 * j] * rs * sigmoidf_(lo16(gw[j])) + (MODE == 1 ? lo16(pw[j]) : 0.f);
                        o[2 * j + 1] = o[2 * j + 1] * rs * sigmoidf_(hi16(gw[j])) + (MODE == 1 ? hi16(pw[j]) : 0.f); }
                    u32x4 w; w.x = pk2(o[0], o[1]); w.y = pk2(o[2], o[3]); w.z = pk2(o[4], o[5]); w.w = pk2(o[6], o[7]);
                    *(u32x4*)(rowp + bj * HALF) = w; asm volatile("" ::: "memory"); } }
    }
};
struct EpiMergeF {
    static constexpr bool PERM = true, HAS_MID = true; static constexpr int MID_T = 32;
    bf16_t* P; const float* rstd;
    DI void mid(f32x4 (&acc)[2][2][4][2], const Unit& u, int wr, int wc, int fr, int fq) const {
        const int row0 = opaque_i(u.pm * BM + wr * 64 + fr), col0 = opaque_i(u.pn * BM + wc * 32 + 8 * fq);
#pragma unroll
        for (int ai = 0; ai < 2; ++ai) {
            u32x4 gs[4][2], gn[4][2]; float rs[4];
#pragma unroll
            for (int m = 0; m < 4; ++m) { const int row = row0 + ai * HALF + m * 16; const bf16_t* rowp = P + (size_t)row * LDP + col0; rs[m] = rstd[row];
#pragma unroll
                for (int bj = 0; bj < 2; ++bj) { gs[m][bj] = *(const u32x4*)(rowp + bj * HALF + C_GLS); gn[m][bj] = *(const u32x4*)(rowp + bj * HALF + C_GLN); } }
#pragma unroll
            for (int m = 0; m < 4; ++m)
#pragma unroll
                for (int bj = 0; bj < 2; ++bj) {
                    const unsigned gsw[4] = {gs[m][bj].x, gs[m][bj].y, gs[m][bj].z, gs[m][bj].w}, gnw[4] = {gn[m][bj].x, gn[m][bj].y, gn[m][bj].z, gn[m][bj].w};
#pragma unroll
                    for (int j = 0; j < 4; ++j) {
                        const float r0 = rs[m] * (1.f + __expf(-lo16(gnw[j]))) * __builtin_amdgcn_rcpf(1.f + __expf(-lo16(gsw[j])));
                        const float r1 = rs[m] * (1.f + __expf(-hi16(gnw[j]))) * __builtin_amdgcn_rcpf(1.f + __expf(-hi16(gsw[j])));
                        acc[ai][bj][m][j >> 1][(j & 1) * 2] *= r0; acc[ai][bj][m][j >> 1][(j & 1) * 2 + 1] *= r1; } }
            asm volatile("" ::: "memory");
        }
    }
    DI void operator()(const f32x4 (&acc)[2][2][4][2], const Unit& u, int wr, int wc, int fr, int fq) const {
        const int row0 = u.pm * BM + wr * 64 + fr, col0 = u.pn * BM + wc * 32 + 8 * fq;
        u32x4 gn[2][4][2];
#pragma unroll
        for (int ai = 0; ai < 2; ++ai)
#pragma unroll
            for (int m = 0; m < 4; ++m) { const bf16_t* rowp = P + (size_t)(row0 + ai * HALF + m * 16) * LDP + col0;
#pragma unroll
                for (int bj = 0; bj < 2; ++bj) gn[ai][m][bj] = *(const u32x4*)(rowp + bj * HALF + C_GLN); }
#pragma unroll
        for (int ai = 0; ai < 2; ++ai)
#pragma unroll
            for (int m = 0; m < 4; ++m) { bf16_t* rowp = P + (size_t)(row0 + ai * HALF + m * 16) * LDP + col0;
#pragma unroll
                for (int bj = 0; bj < 2; ++bj) { const f32x4 v0 = acc[ai][bj][m][0], v1 = acc[ai][bj][m][1];
                    const unsigned gnw[4] = {gn[ai][m][bj].x, gn[ai][m][bj].y, gn[ai][m][bj].z, gn[ai][m][bj].w};
                    const float o[8] = {v0[0], v0[1], v0[2], v0[3], v1[0], v1[1], v1[2], v1[3]};
                    u32x4 w;
                    w.x = pk2(o[0] * sigmoidf_(lo16(gnw[0])), o[1] * sigmoidf_(hi16(gnw[0]))); w.y = pk2(o[2] * sigmoidf_(lo16(gnw[1])), o[3] * sigmoidf_(hi16(gnw[1])));
                    w.z = pk2(o[4] * sigmoidf_(lo16(gnw[2])), o[5] * sigmoidf_(hi16(gnw[2]))); w.w = pk2(o[6] * sigmoidf_(lo16(gnw[3])), o[7] * sigmoidf_(hi16(gnw[3])));
                    *(u32x4*)(rowp + bj * HALF) = w; } }
    }
};
struct EpiOut {
    static constexpr bool PERM = false, HAS_MID = false; static constexpr int MID_T = -1;
    float* C; const float* X;
    DI void operator()(const f32x4 (&acc)[2][2][4][2], const Unit& u, int wr, int wc, int fr, int fq) const {
        const int row0 = u.pm * BM + wr * 64 + fr, col0 = u.pn * BM + wc * 32 + 4 * fq;
#pragma unroll
        for (int ai = 0; ai < 2; ++ai) {
            f32x4 xv[4][2][2];
#pragma unroll
            for (int m = 0; m < 4; ++m) { const size_t off = (size_t)(row0 + ai * HALF + m * 16) * DM + col0;
#pragma unroll
                for (int bj = 0; bj < 2; ++bj)
#pragma unroll
                    for (int n = 0; n < 2; ++n) xv[m][bj][n] = *(const f32x4*)(X + off + bj * HALF + n * 16); }
#pragma unroll
            for (int m = 0; m < 4; ++m) { const size_t off = (size_t)(row0 + ai * HALF + m * 16) * DM + col0;
#pragma unroll
                for (int bj = 0; bj < 2; ++bj)
#pragma unroll
                    for (int n = 0; n < 2; ++n) *(f32x4*)(C + off + bj * HALF + n * 16) = acc[ai][bj][m][n] + xv[m][bj][n]; }
            asm volatile("" ::: "memory");
        }
    }
};
}

DI int win_srccol(int j) {
    if (j < 5120) return j;
    if (j < 10752) return j + 32;
    if (j < 14848) return j + 80;
    if (j < 14880) return j - 14848 + 5120;
    if (j < 14928) return j - 14880 + 10784;
    return -1;
}
DI void transpose_tile(const float* src, int ldsrc, bf16_t* dst, int lddst, int k0, int n0, int mode, const float* rowscale, float* tile) {
    const int tid = opaque_tid();
    {
        const int r = tid >> 4, c4 = (tid & 15) * 4;
#pragma unroll
        for (int q = 0; q < 2; ++q) {
            const int rr = r + 32 * q; const int jd = n0 + c4; const int js = mode ? win_srccol(jd) : jd;
            f32x4 v = {0.f, 0.f, 0.f, 0.f};
            if (js >= 0) v = *(const f32x4*)(src + (size_t)(k0 + rr) * ldsrc + js);
            if (rowscale) { const float sc = rowscale[k0 + rr]; v = v * sc; }
            tile[rr * 65 + c4 + 0] = v[0]; tile[rr * 65 + c4 + 1] = v[1]; tile[rr * 65 + c4 + 2] = v[2]; tile[rr * 65 + c4 + 3] = v[3];
        }
    }
    LDS_BAR();
    {
        const int n = tid >> 3, k8 = (tid & 7) * 8;
        u32x4 w;
        w.x = pk2(tile[(k8 + 0) * 65 + n], tile[(k8 + 1) * 65 + n]); w.y = pk2(tile[(k8 + 2) * 65 + n], tile[(k8 + 3) * 65 + n]);
        w.z = pk2(tile[(k8 + 4) * 65 + n], tile[(k8 + 5) * 65 + n]); w.w = pk2(tile[(k8 + 6) * 65 + n], tile[(k8 + 7) * 65 + n]);
        *(u32x4*)(dst + (size_t)(n0 + n) * lddst + k0 + k8) = w;
    }
    LDS_BAR();
}

DI void phase_prep(const Params& P, unsigned char* smem) {
    const int tid = opaque_tid(), lane = tid & 63, wave = tid >> 6;
    for (int row = blockIdx.x * 8 + wave; row < NTOK; row += gridDim.x * 8) {
        const f32x4* xr = (const f32x4*)(P.x + (size_t)row * DM);
        f32x4 v[8]; float s = 0.f;
#pragma unroll
        for (int j = 0; j < 8; ++j) { v[j] = xr[lane + 64 * j]; s += v[j][0] * v[j][0] + v[j][1] * v[j][1] + v[j][2] * v[j][2] + v[j][3] * v[j][3]; }
        s = wave_sum(s);
        const float rstd = 1.f / sqrtf(s * (1.f / DM) + EPSF);
        u32x2* o = (u32x2*)(P_h + (size_t)row * DM);
#pragma unroll
        for (int j = 0; j < 8; ++j) { const f32x4 w = ((const f32x4*)P.norm_w)[lane + 64 * j]; u32x2 r; r.x = pk2(v[j][0] * rstd * w[0], v[j][1] * rstd * w[1]); r.y = pk2(v[j][2] * rstd * w[2], v[j][3] * rstd * w[3]); o[lane + 64 * j] = r; }
    }
    float* tile = (float*)smem;
    constexpr int I_WIN = 32 * (LDP / 64), I_W1 = 64 * 2, I_W2 = 2 * 2;
    constexpr int NIT = I_WIN + 2 * I_W1 + 2 * I_W2 + 32;
    for (int it = blockIdx.x; it < NIT; it += gridDim.x) {
        int r = it;
        if (r < I_WIN) { const int kb = r & 31, nb = r >> 5; transpose_tile(P.w_in, INDIM, P_winT, DM, kb * 64, nb * 64, 1, nullptr, tile); continue; } r -= I_WIN;
        if (r < I_W1) { transpose_tile(P.cmp_w1_k, 128, P_w1kT, 4096, (r >> 1) * 64, (r & 1) * 64, 0, nullptr, tile); continue; } r -= I_W1;
        if (r < I_W1) { transpose_tile(P.cmp_w1_v, 128, P_w1vT, 4096, (r >> 1) * 64, (r & 1) * 64, 0, nullptr, tile); continue; } r -= I_W1;
        if (r < I_W2) { transpose_tile(P.cmp_w2_k, 128, P_w2kT, 128, (r >> 1) * 64, (r & 1) * 64, 0, nullptr, tile); continue; } r -= I_W2;
        if (r < I_W2) { transpose_tile(P.cmp_w2_v, 128, P_w2vT, 128, (r >> 1) * 64, (r & 1) * 64, 0, nullptr, tile); continue; } r -= I_W2;
        {
            const int which = r >> 4, n0 = (r & 15) * 8;
            const float* pe = which ? P.cmp_pe_v : P.cmp_pe_k; const float* w1 = which ? P.cmp_w1_v : P.cmp_w1_k; const float* b1 = which ? P.cmp_b1_v : P.cmp_b1_k; float* bo = which ? P_biasv : P_biask;
            float acc8[8];
#pragma unroll
            for (int j = 0; j < 8; ++j) acc8[j] = 0.f;
#pragma unroll
            for (int i = 0; i < 8; ++i) { const int kk = tid + 512 * i; const float pv = pe[kk]; const f32x4 wa = *(const f32x4*)(w1 + (size_t)kk * 128 + n0), wb = *(const f32x4*)(w1 + (size_t)kk * 128 + n0 + 4);
                acc8[0] += pv * wa[0]; acc8[1] += pv * wa[1]; acc8[2] += pv * wa[2]; acc8[3] += pv * wa[3]; acc8[4] += pv * wb[0]; acc8[5] += pv * wb[1]; acc8[6] += pv * wb[2]; acc8[7] += pv * wb[3]; }
#pragma unroll
            for (int j = 0; j < 8; ++j) acc8[j] = wave_sum(acc8[j]);
            if (lane == 0) {
#pragma unroll
                for (int j = 0; j < 8; ++j) tile[wave * 8 + j] = acc8[j]; }
            __syncthreads();
            if (tid < 8) { float t = 0.f;
#pragma unroll
                for (int w = 0; w < 8; ++w) t += tile[w * 8 + tid];
                bo[n0 + tid] = b1[n0 + tid] + t; }
            __syncthreads();
        }
    }
}

constexpr int RS = 272;
constexpr int SSD_BS = 0, SSD_BWT = 34816, SSD_CS = 69632, SSD_XT = 104448, SSD_ST = 121856, SSD_CUM = 139264, SSD_WSC = 139776, SSD_DTV = 140288;

DI void phase_bcconv(const Params& P) {
    const int tid = opaque_tid();
    for (int it = blockIdx.x; it < 256; it += gridDim.x) {
        const int b = it >> 4, slab = it & 15; const int cg = tid & 7, seg = tid >> 3;
        const int c = 2048 + slab * 64 + cg * 8;
        bf16_t* base = P_proj + (size_t)b * TT * LDP + C_X + c;
        float w[4][8], bias[8];
#pragma unroll
        for (int k = 0; k < 4; ++k) { const f32x4 a = *(const f32x4*)(P.conv_w + k * 3072 + c), bb = *(const f32x4*)(P.conv_w + k * 3072 + c + 4);
            w[k][0] = a[0]; w[k][1] = a[1]; w[k][2] = a[2]; w[k][3] = a[3]; w[k][4] = bb[0]; w[k][5] = bb[1]; w[k][6] = bb[2]; w[k][7] = bb[3]; }
        { const f32x4 a = *(const f32x4*)(P.conv_b + c), bb = *(const f32x4*)(P.conv_b + c + 4); bias[0] = a[0]; bias[1] = a[1]; bias[2] = a[2]; bias[3] = a[3]; bias[4] = bb[0]; bias[5] = bb[1]; bias[6] = bb[2]; bias[7] = bb[3]; }
        float h[3][8];
        const int ts = seg * 32;
#pragma unroll
        for (int r = 0; r < 3; ++r) { const int t = ts - 3 + r; u32x4 row = {0u, 0u, 0u, 0u}; if (t >= 0) row = *(const u32x4*)(base + (size_t)t * LDP);
            const unsigned uw[4] = {row.x, row.y, row.z, row.w};
#pragma unroll
            for (int j = 0; j < 4; ++j) { h[r][2 * j] = lo16(uw[j]); h[r][2 * j + 1] = hi16(uw[j]); } }
        __syncthreads();
#pragma unroll 1
        for (int i = 0; i < 32; i += 8) {
            u32x4 rows[8];
#pragma unroll
            for (int q = 0; q < 8; ++q) rows[q] = *(const u32x4*)(base + (size_t)(ts + i + q) * LDP);
#pragma unroll
            for (int q = 0; q < 8; ++q) {
                const unsigned uw[4] = {rows[q].x, rows[q].y, rows[q].z, rows[q].w}; float cur[8], o[8];
#pragma unroll
                for (int j = 0; j < 4; ++j) { cur[2 * j] = lo16(uw[j]); cur[2 * j + 1] = hi16(uw[j]); }
#pragma unroll
                for (int j = 0; j < 8; ++j) { o[j] = siluf_(bias[j] + w[0][j] * h[0][j] + w[1][j] * h[1][j] + w[2][j] * h[2][j] + w[3][j] * cur[j]); h[0][j] = h[1][j]; h[1][j] = h[2][j]; h[2][j] = cur[j]; }
                u32x4 ov; ov.x = pk2(o[0], o[1]); ov.y = pk2(o[2], o[3]); ov.z = pk2(o[4], o[5]); ov.w = pk2(o[6], o[7]);
                *(u32x4*)(base + (size_t)(ts + i + q) * LDP) = ov;
            }
        }
        __syncthreads();
    }
}

constexpr int SSD_WCV = 140800;

template <int NT, int ROFF, int NR, int WS = 320>
DI void conv_regs(const u32x4 (&rows)[NR], const float* wl  , float (&out)[NT][8]) {
    float w[5][8];
#pragma unroll
    for (int k = 0; k < 5; ++k) { const f32x4 a = *(const f32x4*)(wl + k * WS), b = *(const f32x4*)(wl + k * WS + 4);
        w[k][0] = a[0]; w[k][1] = a[1]; w[k][2] = a[2]; w[k][3] = a[3]; w[k][4] = b[0]; w[k][5] = b[1]; w[k][6] = b[2]; w[k][7] = b[3]; }
#pragma unroll
    for (int tk = 0; tk < NT; ++tk)
#pragma unroll
        for (int c = 0; c < 8; ++c) out[tk][c] = w[4][c];
#pragma unroll
    for (int r = 0; r < NT + 3; ++r) {
        const u32x4 row = rows[ROFF + r]; const unsigned uw[4] = {row.x, row.y, row.z, row.w};
        float u[8];
#pragma unroll
        for (int j = 0; j < 4; ++j) { u[2 * j] = lo16(uw[j]); u[2 * j + 1] = hi16(uw[j]); }
#pragma unroll
        for (int k = 0; k < 4; ++k) { const int tk = r - k;
            if (tk >= 0 && tk < NT) {
#pragma unroll
                for (int c = 0; c < 8; ++c) out[tk][c] += w[k][c] * u[c]; } }
    }
#pragma unroll
    for (int tk = 0; tk < NT; ++tk)
#pragma unroll
        for (int c = 0; c < 8; ++c) out[tk][c] = siluf_(out[tk][c]);
}

DI void ssd_item(const Params& P, unsigned char* smem, int b, int hd) {
    const int tid0 = opaque_tid();
    const int g = hd >> 3;
    const float Aneg = -__expf(P.a_log[hd]), dtb = P.dt_bias[hd], Dsk = P.d_skip[hd];
    const bf16_t* pbase = P_proj + (size_t)b * TT * LDP;
    float* cum = (float*)(smem + SSD_CUM); float* wsc = (float*)(smem + SSD_WSC); float* dtv = (float*)(smem + SSD_DTV); float* wcv = (float*)(smem + SSD_WCV);
#define SSD_ROLES(tid) \
    const int lane = tid & 63, wave = tid >> 6, l32o = lane & 31, hho = lane >> 5, l32 = l32o, hh = hho; \
    const int lt = wave & 3, ph = wave >> 2; \
    const int cgi = tid & 31, run = tid >> 5; \
    const int chbc = (cgi < 16 ? 2048 + g * 128 + cgi * 8 : 2560 + g * 128 + (cgi - 16) * 8); \
    const int cgx = tid & 7, runx = tid >> 3; const int chx = hd * 64 + cgx * 8;
    __syncthreads();
    for (int i = tid0; i < 5 * 320; i += 512) { const int k = i / 320, c = i % 320; const int ch = c < 128 ? 2048 + g * 128 + c : (c < 256 ? 2560 + g * 128 + (c - 128) : hd * 64 + (c - 256));
        wcv[i] = (k < 4) ? P.conv_w[k * 3072 + ch] : P.conv_b[ch]; }
    f32x16 state;
#pragma unroll
    for (int i = 0; i < 16; ++i) state[i] = 0.f;
    u32x4 rbc[8], rx[5]; u32x2 zr[4]; float dr0 = 0.f, dr1 = 0.f;
#define SSD_BAR() do { asm volatile("s_waitcnt lgkmcnt(0)" ::: "memory"); __builtin_amdgcn_s_barrier(); asm volatile("" ::: "memory"); } while (0)
#define SSD_ISSUE_Z(T0) do { _Pragma("unroll") for (int ig = 0; ig < 4; ++ig) zr[ig] = *(const u32x2*)(pbase + (size_t)((T0) + 32 * lt + l32o) * LDP + C_Z + hd * 64 + 32 * ph + 8 * ig + 4 * hho); } while (0)
#define SSD_ISSUE(T0) do { \
        _Pragma("unroll") for (int r = 0; r < 8; ++r) { const int t = (T0) + run * 8 + r; rbc[r] = *(const u32x4*)(pbase + (size_t)t * LDP + C_X + chbc); } \
        _Pragma("unroll") for (int r = 0; r < 5; ++r) { const int t = (T0) + runx * 2 - 3 + r; rx[r] = (u32x4){0u, 0u, 0u, 0u}; if (t >= 0) rx[r] = *(const u32x4*)(pbase + (size_t)t * LDP + C_X + chx); } \
        if (wave == 0) { dr0 = bf2f(pbase[(size_t)((T0) + lane) * LDP + C_DT + hd]); dr1 = bf2f(pbase[(size_t)((T0) + 64 + lane) * LDP + C_DT + hd]); } } while (0)
    { SSD_ROLES(tid0) SSD_ISSUE(0); SSD_ISSUE_Z(0); }

    for (int c = 0; c < 16; ++c) {
        const int t0 = c * 128; const int tidc = opaque_i(tid0);
        SSD_ROLES(tidc)
        SSD_BAR();
        if (wave == 0) {
            const float r0 = dr0 + dtb, r1 = dr1 + dtb;
            const float d0 = r0 > 20.f ? r0 : log1pf(__expf(r0)), d1 = r1 > 20.f ? r1 : log1pf(__expf(r1));
            float c0 = d0 * Aneg, c1 = d1 * Aneg;
#pragma unroll
            for (int o = 1; o < 64; o <<= 1) { const float a0 = __shfl_up(c0, o), a1 = __shfl_up(c1, o); if (lane >= o) { c0 += a0; c1 += a1; } }
            const float tot0 = __shfl(c0, 63); c1 += tot0;
            const float last = __shfl(c1, 63);
            cum[lane] = c0; cum[64 + lane] = c1; dtv[lane] = d0; dtv[64 + lane] = d1;
            wsc[lane] = d0 * __expf(last - c0); wsc[64 + lane] = d1 * __expf(last - c1);
        }
        {
            const int o1 = opaque_i((32 * ph + 4 * hh) * RS + (32 * lt + l32) * 2);
#pragma unroll
            for (int i = 0; i < 16; ++i) *(bf16_t*)(smem + SSD_ST + o1 + ((i & 3) + 8 * (i >> 2)) * RS) = f2bf(state[i]);
        }
        SSD_BAR();
        {
            if (cgi < 16) {
                const int n0 = cgi * 8;
#pragma unroll
                for (int r = 0; r < 8; ++r) *(u32x4*)(smem + SSD_BS + (run * 8 + r) * RS + n0 * 2) = rbc[r];
                const f32x4 wsa = *(const f32x4*)(wsc + run * 8), wsb = *(const f32x4*)(wsc + run * 8 + 4);
                const float ws8[8] = {wsa[0], wsa[1], wsa[2], wsa[3], wsb[0], wsb[1], wsb[2], wsb[3]};
#pragma unroll
                for (int cc = 0; cc < 8; ++cc) { float v[8];
#pragma unroll
                    for (int r = 0; r < 8; ++r) { const unsigned wd = (cc >> 1) == 0 ? rbc[r].x : ((cc >> 1) == 1 ? rbc[r].y : ((cc >> 1) == 2 ? rbc[r].z : rbc[r].w)); v[r] = ((cc & 1) ? hi16(wd) : lo16(wd)) * ws8[r]; }
                    u32x4 w; w.x = pk2(v[0], v[1]); w.y = pk2(v[2], v[3]); w.z = pk2(v[4], v[5]); w.w = pk2(v[6], v[7]);
                    *(u32x4*)(smem + SSD_BWT + (n0 + cc) * RS + run * 16) = w; }
            } else {
                const int n0 = (cgi - 16) * 8;
#pragma unroll
                for (int r = 0; r < 8; ++r) *(u32x4*)(smem + SSD_CS + (run * 8 + r) * RS + n0 * 2) = rbc[r];
            }
            float ox[2][8];
            conv_regs<2, 0, 5>(rx, wcv + 256 + cgx * 8, ox);
#pragma unroll
            for (int cc = 0; cc < 8; ++cc) *(unsigned*)(smem + SSD_XT + (cgx * 8 + cc) * RS + runx * 4) = pk2(ox[0][cc], ox[1][cc]);
        }
        SSD_BAR();
        if (c < 15) SSD_ISSUE(t0 + 128);
        {
            const int l32 = opaque_i(l32o), hh = opaque_i(hho);
            const int l = 32 * lt + l32;
            const unsigned char* cfp = smem + SSD_CS + l * RS + 16 * hh;
#define CF(ks) (*(const bf16x8*)(cfp + 32 * (ks)))
            f32x16 acc;
#pragma unroll
            for (int i = 0; i < 16; ++i) acc[i] = 0.f;
#pragma unroll
            for (int ks = 0; ks < 8; ++ks) { const bf16x8 a = *(const bf16x8*)(smem + SSD_ST + (32 * ph + l32) * RS + (16 * ks + 8 * hh) * 2); acc = MFMA32(a, CF(ks), acc); }
            const float cl = cum[l];
            { const float e = __expf(cl);
#pragma unroll
              for (int i = 0; i < 16; ++i) acc[i] *= e; }
            for (int st = 0; st <= lt; ++st) {
                f32x16 S;
#pragma unroll
                for (int i = 0; i < 16; ++i) S[i] = 0.f;
#pragma unroll
                for (int ks = 0; ks < 8; ++ks) { const bf16x8 a = *(const bf16x8*)(smem + SSD_BS + (32 * st + l32) * RS + (16 * ks + 8 * hh) * 2); S = MFMA32(a, CF(ks), S); }
#pragma unroll
                for (int ig = 0; ig < 4; ++ig) { const int s0 = 32 * st + 8 * ig + 4 * hh; const f32x4 cs = *(const f32x4*)(cum + s0), dv = *(const f32x4*)(dtv + s0);
#pragma unroll
                    for (int j = 0; j < 4; ++j) { const float dec = __expf(fminf(cl - cs[j], 0.f)) * dv[j]; S[4 * ig + j] = (s0 + j <= l) ? S[4 * ig + j] * dec : 0.f; } }
#pragma unroll
                for (int s2 = 0; s2 < 2; ++s2) {
                    const bf16x8 mf = pack8(S, s2);
                    const unsigned char* xp = smem + SSD_XT + (32 * ph + l32) * RS + (32 * st + 16 * s2 + 4 * hh) * 2;
                    const bf16x8 a = cat44(*(const s16x4*)xp, *(const s16x4*)(xp + 16));
                    acc = MFMA32(a, mf, acc);
                }
            }
            const size_t tok = (size_t)b * TT + t0 + l; float ss = 0.f;
            const int xo = opaque_i((32 * ph + 4 * hh) * RS + l * 2);
#pragma unroll
            for (int ig = 0; ig < 4; ++ig) { const int p0 = 32 * ph + 8 * ig + 4 * hh;
                const u32x2 zz = zr[ig];
                const float zf[4] = {lo16(zz.x), hi16(zz.x), lo16(zz.y), hi16(zz.y)}; float y[4];
#pragma unroll
                for (int j = 0; j < 4; ++j) { const float xv = bf2f(*(const bf16_t*)(smem + SSD_XT + xo + (8 * ig + j) * RS)); y[j] = (acc[4 * ig + j] + Dsk * xv) * siluf_(zf[j]); ss += y[j] * y[j]; }
                u32x2 w; w.x = pk2(y[0], y[1]); w.y = pk2(y[2], y[3]);
                *(u32x2*)(P_yg + tok * 4096 + hd * 64 + p0) = w; }
            ss += __shfl_xor(ss, 32);
            if (hh == 0) P_part[tok * 64 + hd * 2 + ph] = ss;
            { const float e = __expf(cum[127]);
#pragma unroll
              for (int i = 0; i < 16; ++i) state[i] *= e; }
#pragma unroll
            for (int ks = 0; ks < 8; ++ks) {
                const bf16x8 a = *(const bf16x8*)(smem + SSD_XT + (32 * ph + l32) * RS + (16 * ks + 8 * hh) * 2);
                const bf16x8 bb = *(const bf16x8*)(smem + SSD_BWT + (32 * lt + l32) * RS + (16 * ks + 8 * hh) * 2);
                state = MFMA32(a, bb, state);
            }
            if (c < 15) SSD_ISSUE_Z(t0 + 128);
        }
    }
#undef SSD_ISSUE_Z
#undef SSD_ISSUE
#undef SSD_BAR
#undef CF
#undef SSD_ROLES
}

constexpr int RS2 = 144;
constexpr int S2_BS = 0, S2_CS = 17408, S2_HALF0 = 34816, S2_HSTRIDE = 47104;
constexpr int S2_BWT = 0, S2_XT = 18432, S2_ST = 27648, S2_CUM = 45056, S2_WSC = 45312, S2_DTV = 45568, S2_WCV = 45824;

DI void ssd_pair_item(const Params& P, unsigned char* smem, int b, int hp) {
    const int tid0 = opaque_tid();
    const int hd = 2 * hp + (tid0 >> 8), g = hp >> 2;
    const float Aneg = -__expf(P.a_log[hd]), dtb = P.dt_bias[hd], Dsk = P.d_skip[hd];
    const bf16_t* pbase = P_proj + (size_t)b * TT * LDP;
    unsigned char* hb = smem + S2_HALF0 + (tid0 >> 8) * S2_HSTRIDE;
    float* cum = (float*)(hb + S2_CUM); float* wsc = (float*)(hb + S2_WSC); float* dtv = (float*)(hb + S2_DTV); float* wcv = (float*)(hb + S2_WCV);
#define S2_ROLES(tid) \
    const int lane = tid & 63, wave = tid >> 6, wl = wave & 3, half = wave >> 2, l32o = lane & 31, hho = lane >> 5, l32 = l32o, hh = hho; \
    const int lt = wl & 1, ph = wl >> 1, tidh = tid & 255; \
    const int cg = tidh & 15, run = tidh >> 4; const int chb = 2048 + g * 128 + cg * 8, chc = 2560 + g * 128 + cg * 8; \
    const int cgx = tidh & 7, runx = tidh >> 3; const int chx = hd * 64 + cgx * 8;
    __syncthreads();
    for (int i = (tid0 & 255); i < 5 * 64; i += 256) { const int k = i >> 6, c = i & 63; const int ch = hd * 64 + c; wcv[i] = (k < 4) ? P.conv_w[k * 3072 + ch] : P.conv_b[ch]; }
    f32x16 state[2];
#pragma unroll
    for (int i = 0; i < 16; ++i) { state[0][i] = 0.f; state[1][i] = 0.f; }
    u32x4 rb[4], rc[4], rx[5]; u32x2 zr[4]; float dr0 = 0.f;
#pragma unroll
    for (int r = 0; r < 4; ++r) rc[r] = (u32x4){0u, 0u, 0u, 0u};
#define S2_BAR() do { asm volatile("s_waitcnt lgkmcnt(0)" ::: "memory"); __builtin_amdgcn_s_barrier(); asm volatile("" ::: "memory"); } while (0)
#define S2_ISSUE_Z(T0) do { _Pragma("unroll") for (int ig = 0; ig < 4; ++ig) zr[ig] = *(const u32x2*)(pbase + (size_t)((T0) + 32 * lt + l32o) * LDP + C_Z + hd * 64 + 32 * ph + 8 * ig + 4 * hho); } while (0)
#define S2_ISSUE(T0) do { \
        _Pragma("unroll") for (int r = 0; r < 4; ++r) { const int t = (T0) + run * 4 + r; rb[r] = *(const u32x4*)(pbase + (size_t)t * LDP + C_X + chb); if (half) rc[r] = *(const u32x4*)(pbase + (size_t)t * LDP + C_X + chc); } \
        _Pragma("unroll") for (int r = 0; r < 5; ++r) { const int t = (T0) + runx * 2 - 3 + r; rx[r] = (u32x4){0u, 0u, 0u, 0u}; if (t >= 0) rx[r] = *(const u32x4*)(pbase + (size_t)t * LDP + C_X + chx); } \
        if (wl == 0) dr0 = bf2f(pbase[(size_t)((T0) + lane) * LDP + C_DT + hd]); } while (0)
    { S2_ROLES(tid0) S2_ISSUE(0); S2_ISSUE_Z(0); }

    for (int c = 0; c < 32; ++c) {
        const int t0 = c * 64; const int tidc = opaque_i(tid0);
        S2_ROLES(tidc)
        S2_BAR();
        if (wl == 0) {
            const float r0 = dr0 + dtb;
            const float d0 = r0 > 20.f ? r0 : log1pf(__expf(r0));
            float c0 = d0 * Aneg;
#pragma unroll
            for (int o = 1; o < 64; o <<= 1) { const float a0 = __shfl_up(c0, o); if (lane >= o) c0 += a0; }
            const float last = __shfl(c0, 63);
            cum[lane] = c0; dtv[lane] = d0; wsc[lane] = d0 * __expf(last - c0);
        }
        {
#pragma unroll
            for (int q = 0; q < 2; ++q) {
                const int o1 = opaque_i((32 * ph + 4 * hh) * RS + (32 * (2 * lt + q) + l32) * 2);
#pragma unroll
                for (int i = 0; i < 16; ++i) *(bf16_t*)(hb + S2_ST + o1 + ((i & 3) + 8 * (i >> 2)) * RS) = f2bf(state[q][i]);
            }
        }
        S2_BAR();
        {
            if (half == 0) {
#pragma unroll
                for (int r = 0; r < 4; ++r) *(u32x4*)(smem + S2_BS + (run * 4 + r) * RS + cg * 16) = rb[r];
            } else {
#pragma unroll
                for (int r = 0; r < 4; ++r) *(u32x4*)(smem + S2_CS + (run * 4 + r) * RS + cg * 16) = rc[r];
            }
            const f32x4 ws4 = *(const f32x4*)(wsc + run * 4);
#pragma unroll
            for (int cc = 0; cc < 8; ++cc) { float v[4];
#pragma unroll
                for (int r = 0; r < 4; ++r) { const unsigned wd = (cc >> 1) == 0 ? rb[r].x : ((cc >> 1) == 1 ? rb[r].y : ((cc >> 1) == 2 ? rb[r].z : rb[r].w)); v[r] = ((cc & 1) ? hi16(wd) : lo16(wd)) * ws4[r]; }
                u32x2 w; w.x = pk2(v[0], v[1]); w.y = pk2(v[2], v[3]);
                *(u32x2*)(hb + S2_BWT + (cg * 8 + cc) * RS2 + run * 8) = w; }
            float ox[2][8];
            conv_regs<2, 0, 5, 64>(rx, wcv + cgx * 8, ox);
#pragma unroll
            for (int cc = 0; cc < 8; ++cc) *(unsigned*)(hb + S2_XT + (cgx * 8 + cc) * RS2 + runx * 4) = pk2(ox[0][cc], ox[1][cc]);
        }
        S2_BAR();
        if (c < 31) S2_ISSUE(t0 + 64);
        {
            const int l32 = opaque_i(l32o), hh = opaque_i(hho);
            const int l = 32 * lt + l32;
            const unsigned char* cfp = smem + S2_CS + l * RS + 16 * hh;
#define CF2(ks) (*(const bf16x8*)(cfp + 32 * (ks)))
            f32x16 acc;
#pragma unroll
            for (int i = 0; i < 16; ++i) acc[i] = 0.f;
#pragma unroll
            for (int ks = 0; ks < 8; ++ks) { const bf16x8 a = *(const bf16x8*)(hb + S2_ST + (32 * ph + l32) * RS + (16 * ks + 8 * hh) * 2); acc = MFMA32(a, CF2(ks), acc); }
            const float cl = cum[l];
            { const float e = __expf(cl);
#pragma unroll
              for (int i = 0; i < 16; ++i) acc[i] *= e; }
            for (int st = 0; st <= lt; ++st) {
                f32x16 S;
#pragma unroll
                for (int i = 0; i < 16; ++i) S[i] = 0.f;
#pragma unroll
                for (int ks = 0; ks < 8; ++ks) { const bf16x8 a = *(const bf16x8*)(smem + S2_BS + (32 * st + l32) * RS + (16 * ks + 8 * hh) * 2); S = MFMA32(a, CF2(ks), S); }
#pragma unroll
                for (int ig = 0; ig < 4; ++ig) { const int s0 = 32 * st + 8 * ig + 4 * hh; const f32x4 cs = *(const f32x4*)(cum + s0), dv = *(const f32x4*)(dtv + s0);
#pragma unroll
                    for (int j = 0; j < 4; ++j) { const float dec = __expf(fminf(cl - cs[j], 0.f)) * dv[j]; S[4 * ig + j] = (s0 + j <= l) ? S[4 * ig + j] * dec : 0.f; } }
#pragma unroll
                for (int s2 = 0; s2 < 2; ++s2) {
                    const bf16x8 mf = pack8(S, s2);
                    const unsigned char* xp = hb + S2_XT + (32 * ph + l32) * RS2 + (32 * st + 16 * s2 + 4 * hh) * 2;
                    const bf16x8 a = cat44(*(const s16x4*)xp, *(const s16x4*)(xp + 16));
                    acc = MFMA32(a, mf, acc);
                }
            }
            const size_t tok = (size_t)b * TT + t0 + l; float ss = 0.f;
            const int xo = opaque_i((32 * ph + 4 * hh) * RS2 + l * 2);
#pragma unroll
            for (int ig = 0; ig < 4; ++ig) { const int p0 = 32 * ph + 8 * ig + 4 * hh;
                const u32x2 zz = zr[ig];
                const float zf[4] = {lo16(zz.x), hi16(zz.x), lo16(zz.y), hi16(zz.y)}; float y[4];
#pragma unroll
                for (int j = 0; j < 4; ++j) { const float xv = bf2f(*(const bf16_t*)(hb + S2_XT + xo + (8 * ig + j) * RS2)); y[j] = (acc[4 * ig + j] + Dsk * xv) * siluf_(zf[j]); ss += y[j] * y[j]; }
                u32x2 w; w.x = pk2(y[0], y[1]); w.y = pk2(y[2], y[3]);
                *(u32x2*)(P_yg + tok * 4096 + hd * 64 + p0) = w; }
            ss += __shfl_xor(ss, 32);
            if (hh == 0) P_part[tok * 64 + hd * 2 + ph] = ss;
            { const float e = __expf(cum[63]);
#pragma unroll
              for (int i = 0; i < 16; ++i) { state[0][i] *= e; state[1][i] *= e; } }
#pragma unroll
            for (int ks = 0; ks < 4; ++ks) {
                const bf16x8 a = *(const bf16x8*)(hb + S2_XT + (32 * ph + l32) * RS2 + (16 * ks + 8 * hh) * 2);
#pragma unroll
                for (int q = 0; q < 2; ++q) { const bf16x8 bb = *(const bf16x8*)(hb + S2_BWT + (32 * (2 * lt + q) + l32) * RS2 + (16 * ks + 8 * hh) * 2); state[q] = MFMA32(a, bb, state[q]); }
            }
            if (c < 31) S2_ISSUE_Z(t0 + 64);
        }
    }
#undef S2_ISSUE_Z
#undef S2_ISSUE
#undef S2_BAR
#undef CF2
#undef S2_ROLES
}

DI void knorm16(const u32x4 a, const u32x4 c2, const float* nw, u32x4& o0, u32x4& o1) {
    const unsigned uw[8] = {a.x, a.y, a.z, a.w, c2.x, c2.y, c2.z, c2.w}; float v[16]; float s = 0.f;
#pragma unroll
    for (int j = 0; j < 8; ++j) { v[2 * j] = lo16(uw[j]); v[2 * j + 1] = hi16(uw[j]); s += v[2 * j] * v[2 * j] + v[2 * j + 1] * v[2 * j + 1]; }
    s += __shfl_xor(s, 1); s += __shfl_xor(s, 2); s += __shfl_xor(s, 4);
    const float rstd = 1.f / sqrtf(s * (1.f / 128.f) + EPSF);
    o0.x = pk2(v[0] * rstd * nw[0], v[1] * rstd * nw[1]); o0.y = pk2(v[2] * rstd * nw[2], v[3] * rstd * nw[3]); o0.z = pk2(v[4] * rstd * nw[4], v[5] * rstd * nw[5]); o0.w = pk2(v[6] * rstd * nw[6], v[7] * rstd * nw[7]);
    o1.x = pk2(v[8] * rstd * nw[8], v[9] * rstd * nw[9]); o1.y = pk2(v[10] * rstd * nw[10], v[11] * rstd * nw[11]); o1.z = pk2(v[12] * rstd * nw[12], v[13] * rstd * nw[13]); o1.w = pk2(v[14] * rstd * nw[14], v[15] * rstd * nw[15]);
}
DI void kvprep_item(const Params& P, unsigned char* smem, int item) {
    const int tid = opaque_tid(); const int tt = item & 31, g = (item >> 5) & 1, b = item >> 6; const int t0 = tt * 64;
    bf16_t* pb = P_proj + ((size_t)b * TT + t0) * LDP;
    const int tk = tid >> 3, part = tid & 7;
    bf16_t* kp0 = pb + (size_t)tk * LDP + C_KSLC + g * 128 + part * 16; bf16_t* kp1 = pb + (size_t)tk * LDP + C_KWIN + g * 128 + part * 16;
    const bf16_t* vp0 = pb + (size_t)tk * LDP + C_VSLC + g * 128 + part * 16; const bf16_t* vp1 = pb + (size_t)tk * LDP + C_VWIN + g * 128 + part * 16;
    const u32x4 k0a = *(const u32x4*)kp0, k0b = *(const u32x4*)(kp0 + 8), k1a = *(const u32x4*)kp1, k1b = *(const u32x4*)(kp1 + 8);
    const u32x4 v0a = *(const u32x4*)vp0, v0b = *(const u32x4*)(vp0 + 8), v1a = *(const u32x4*)vp1, v1b = *(const u32x4*)(vp1 + 8);
    { u32x4 o0, o1; knorm16(k0a, k0b, P.k_slc_norm_w + part * 16, o0, o1); *(u32x4*)kp0 = o0; *(u32x4*)(kp0 + 8) = o1;
      knorm16(k1a, k1b, P.k_win_norm_w + part * 16, o0, o1); *(u32x4*)kp1 = o0; *(u32x4*)(kp1 + 8) = o1; }
    bf16_t* tile0 = (bf16_t*)smem; bf16_t* tile1 = tile0 + 64 * 130;
    LDS_BAR();
    { unsigned* tp = (unsigned*)(tile0 + tk * 130 + part * 16); const unsigned uw[8] = {v0a.x, v0a.y, v0a.z, v0a.w, v0b.x, v0b.y, v0b.z, v0b.w};
#pragma unroll
      for (int j = 0; j < 8; ++j) tp[j] = uw[j];
      unsigned* tq = (unsigned*)(tile1 + tk * 130 + part * 16); const unsigned ux[8] = {v1a.x, v1a.y, v1a.z, v1a.w, v1b.x, v1b.y, v1b.z, v1b.w};
#pragma unroll
      for (int j = 0; j < 8; ++j) tq[j] = ux[j]; }
    LDS_BAR();
    { const int d = tid >> 2, prt = tid & 3;
#pragma unroll
      for (int which = 0; which < 2; ++which) { const bf16_t* tile = which ? tile1 : tile0; unsigned w[8];
#pragma unroll
          for (int j = 0; j < 8; ++j) w[j] = (unsigned)tile[(prt * 16 + 2 * j) * 130 + d] | ((unsigned)tile[(prt * 16 + 2 * j + 1) * 130 + d] << 16);
          bf16_t* op = (which ? P_vwinT : P_vslcT) + ((size_t)(b * 2 + g) * 128 + d) * TT + t0 + prt * 16;
          *(u32x4*)op = (u32x4){w[0], w[1], w[2], w[3]}; *(u32x4*)(op + 8) = (u32x4){w[4], w[5], w[6], w[7]}; } }
    LDS_BAR();
}

DI void compress_item(const Params& P, unsigned char* smem, int item) {
    const int tid = opaque_tid(), lane = tid & 63, wave = tid >> 6, l32 = lane & 31, hh = lane >> 5;
    const int ct = item & 3, g = (item >> 2) & 1, b = (item >> 3) & 15, which = item >> 7;
    const int nt = wave & 3, kh = wave >> 2;
    const bf16_t* src = P_proj + (size_t)b * TT * LDP + (which ? C_VCMP : C_KCMP) + g * 128;
    const bf16_t* w1T = which ? P_w1vT : P_w1kT; const bf16_t* w2T = which ? P_w2vT : P_w2kT; const float* bias = which ? P_biasv : P_biask;
    float* red = (float*)smem;
    bf16_t* hid = (bf16_t*)(smem + 16384);
    float* outf = (float*)(smem + 32768);
    int crow_a = ct * 32 + l32; if (crow_a > 126) crow_a = 126;
    f32x16 acc;
#pragma unroll
    for (int i = 0; i < 16; ++i) acc[i] = 0.f;
#pragma unroll 4
    for (int l = 16 * kh; l < 16 * kh + 16; ++l) {
        const bf16_t* arow = src + (size_t)(16 * crow_a + l) * LDP; const bf16_t* brow = w1T + (size_t)(32 * nt + l32) * 4096 + l * 128;
#pragma unroll
        for (int ks = 0; ks < 8; ++ks) { const bf16x8 a = *(const bf16x8*)(arow + 16 * ks + 8 * hh), bb = *(const bf16x8*)(brow + 16 * ks + 8 * hh); acc = MFMA32(a, bb, acc); }
    }
    __syncthreads();
    if (kh == 1) {
#pragma unroll
        for (int i = 0; i < 16; ++i) red[(nt * 64 + lane) * 16 + i] = acc[i]; }
    __syncthreads();
    if (kh == 0) {
        const float bn = bias[32 * nt + l32];
#pragma unroll
        for (int i = 0; i < 16; ++i) { const float v = acc[i] + red[(nt * 64 + lane) * 16 + i] + bn; hid[crow(i, hh) * 136 + 32 * nt + l32] = f2bf(siluf_(v)); } }
    __syncthreads();
    if (kh == 0) {
        f32x16 o;
#pragma unroll
        for (int i = 0; i < 16; ++i) o[i] = 0.f;
#pragma unroll
        for (int ks = 0; ks < 8; ++ks) { const bf16x8 a = *(const bf16x8*)(hid + l32 * 136 + 16 * ks + 8 * hh), bb = *(const bf16x8*)(w2T + (size_t)(32 * nt + l32) * 128 + 16 * ks + 8 * hh); o = MFMA32(a, bb, o); }
#pragma unroll
        for (int i = 0; i < 16; ++i) outf[crow(i, hh) * 132 + 32 * nt + l32] = o[i];
    }
    __syncthreads();
    if (which == 0) {
        const int r = tid >> 4, part = tid & 15; float v[8]; float s = 0.f;
#pragma unroll
        for (int j = 0; j < 8; ++j) { v[j] = outf[r * 132 + part * 8 + j]; s += v[j] * v[j]; }
        s += __shfl_xor(s, 1); s += __shfl_xor(s, 2); s += __shfl_xor(s, 4); s += __shfl_xor(s, 8);
        const float rstd = 1.f / sqrtf(s * (1.f / 128.f) + EPSF); const float* nw = P.k_cmp_norm_w + part * 8;
        const int cidx = ct * 32 + r; u32x4 w = {0u, 0u, 0u, 0u};
        if (cidx < 127) { w.x = pk2(v[0] * rstd * nw[0], v[1] * rstd * nw[1]); w.y = pk2(v[2] * rstd * nw[2], v[3] * rstd * nw[3]); w.z = pk2(v[4] * rstd * nw[4], v[5] * rstd * nw[5]); w.w = pk2(v[6] * rstd * nw[6], v[7] * rstd * nw[7]); }
        *(u32x4*)(P_kc + ((size_t)(b * 2 + g) * 128 + cidx) * 128 + part * 8) = w;
    } else {
        const int d = tid >> 2, part = tid & 3; unsigned w[4];
#pragma unroll
        for (int j = 0; j < 4; ++j) { const int r0 = part * 8 + 2 * j; const float v0 = (ct * 32 + r0 < 127) ? outf[r0 * 132 + d] : 0.f, v1 = (ct * 32 + r0 + 1 < 127) ? outf[(r0 + 1) * 132 + d] : 0.f; w[j] = pk2(v0, v1); }
        *(u32x4*)(P_vcT + ((size_t)(b * 2 + g) * 128 + d) * 128 + ct * 32 + part * 8) = (u32x4){w[0], w[1], w[2], w[3]};
    }
    __syncthreads();
}

DI void phase_mix(const Params& P, unsigned char* smem) {
    constexpr int I_SSD = 256, I_KV = 1024, I_CMP = 256, I_WT = 3 * 1024;
    constexpr int NIT = I_SSD + I_KV + I_CMP + I_WT;
    for (int it = blockIdx.x; it < NIT; it += gridDim.x) {
        int r = it;
        if (r < I_SSD) { ssd_pair_item(P, smem, r >> 4, r & 15); __syncthreads(); continue; } r -= I_SSD;
        if (r < I_KV) { kvprep_item(P, smem, r); continue; } r -= I_KV;
        if (r < I_CMP) { compress_item(P, smem, r); continue; } r -= I_CMP;
        { const int m = r >> 10, t = r & 1023, kb = t & 31, nb = t >> 5; float* tile = (float*)smem;
          if (m == 0) transpose_tile(P.w_out_ssd, DM, P_wossdT, 4096, kb * 64, nb * 64, 0, P.ssd_norm_w, tile);
          else if (m == 1) transpose_tile(P.w_out_nsa, DM, P_wossdT + 2048, 4096, kb * 64, nb * 64, 0, nullptr, tile);
          else transpose_tile(P.w_o, DM, P_woT, DM, kb * 64, nb * 64, 0, nullptr, tile); }
    }
}

constexpr int NSA_WAVE_LDS = 16384, NSA_K_OFF = 0, NSA_V_OFF = 8192;
constexpr float SM_SCALE = 0.08838834764831845f * 1.4426950408889634f;

struct AttnState { f32x16 acc[4]; float m, l; };

DI void dma_k_tile(LAS unsigned char* wl, const bf16_t* krow0, unsigned kstride_b, int lane) {
    const int rr = lane >> 4, c0 = (lane & 15) ^ rr;
    const unsigned lo = (unsigned)rr * kstride_b;
#pragma unroll
    for (int j = 0; j < 8; ++j) { const unsigned voff = lo + (unsigned)((c0 ^ ((4 * j) & 15)) * 16); const char* ub = (const char*)krow0 + (size_t)(4 * j) * kstride_b;
        __builtin_amdgcn_global_load_lds((const unsigned*)(ub + voff), (LAS unsigned*)(wl + NSA_K_OFF + j * 1024), 16, 0, 0); }
}
DI void dma_v_tile(LAS unsigned char* wl, const bf16_t* vcol0, unsigned vtstride_b, int lane) {
    const int dr = lane >> 2, vpos = lane & 3;
    const unsigned voff = (unsigned)dr * vtstride_b + (unsigned)((vpos ^ ((dr >> 2) & 3)) * 16);
#pragma unroll
    for (int j = 0; j < 8; ++j) { const char* ub = (const char*)vcol0 + (size_t)(16 * j) * vtstride_b;
        __builtin_amdgcn_global_load_lds((const unsigned*)(ub + voff), (LAS unsigned*)(wl + NSA_V_OFF + j * 1024), 16, 0, 0); }
}
DI f32x16 qk_tile(LAS unsigned char* wl, const bf16x8 (&qf)[8], int lane) {
    const int l32 = lane & 31, hh = lane >> 5;
    f32x16 S;
#pragma unroll
    for (int i = 0; i < 16; ++i) S[i] = 0.f;
#pragma unroll
    for (int ks = 0; ks < 8; ++ks) { const bf16x8 a = *(const LAS bf16x8*)(wl + NSA_K_OFF + l32 * 256 + (((2 * ks + hh) ^ (l32 & 15)) * 16)); S = MFMA32(a, qf[ks], S); }
    return S;
}

template <int MODE>
DI void attn_tile(LAS unsigned char* wl, const bf16_t* kbase, unsigned kstride, const bf16_t* vtbase, unsigned vtstride, int key_base, const bf16x8 (&qf)[8],
                  AttnState& st, int tq, bool rowsel, int lane_in) {
    const int lane = opaque_i(lane_in);
    const int l32 = lane & 31, hh = lane >> 5;
    LDS_FENCE();
    dma_k_tile(wl, kbase + (size_t)key_base * kstride, kstride * 2u, lane);
    dma_v_tile(wl, vtbase + key_base, vtstride * 2u, lane);
    asm volatile("s_waitcnt vmcnt(8)" ::: "memory");
    f32x16 S = qk_tile(wl, qf, lane);
    float mx = -1e30f;
#pragma unroll
    for (int i = 0; i < 16; ++i) { const int pos = key_base + crow(i, hh); bool ok;
        if (MODE == 0) ok = (16 * pos + 31 <= tq); else if (MODE == 1) ok = rowsel && (pos <= tq); else ok = (pos <= tq) && (pos > tq - 512);
        const float xv = ok ? S[i] * SM_SCALE : -1e30f; S[i] = xv; mx = fmaxf(mx, xv); }
    mx = fmaxf(mx, __shfl_xor(mx, 32));
    const float mnew = fmaxf(st.m, mx), alpha = __builtin_amdgcn_exp2f(st.m - mnew); float ps = 0.f;
#pragma unroll
    for (int i = 0; i < 16; ++i) { const float p = (S[i] > -1e29f) ? __builtin_amdgcn_exp2f(S[i] - mnew) : 0.f; S[i] = p; ps += p; }
    ps += __shfl_xor(ps, 32);
    st.l = st.l * alpha + ps; st.m = mnew;
#pragma unroll
    for (int dt = 0; dt < 4; ++dt)
#pragma unroll
        for (int i = 0; i < 16; ++i) st.acc[dt][i] *= alpha;
    const bf16x8 p0 = pack8(S, 0), p1 = pack8(S, 1);
    asm volatile("s_waitcnt vmcnt(0)" ::: "memory");
#pragma unroll
    for (int dt = 0; dt < 4; ++dt) {
        const int d = 32 * dt + l32, sw = (d >> 2) & 3;
        LAS unsigned char* vp = wl + NSA_V_OFF + d * 64 + 8 * hh;
        const bf16x8 a0 = cat44(*(const LAS s16x4*)(vp + ((0 ^ sw) * 16)), *(const LAS s16x4*)(vp + ((1 ^ sw) * 16))), a1 = cat44(*(const LAS s16x4*)(vp + ((2 ^ sw) * 16)), *(const LAS s16x4*)(vp + ((3 ^ sw) * 16)));
        st.acc[dt] = MFMA32(a0, p0, st.acc[dt]); st.acc[dt] = MFMA32(a1, p1, st.acc[dt]);
    }
}

DI void attn_reset(AttnState& st) {
    st.m = -1e30f; st.l = 0.f;
#pragma unroll
    for (int dt = 0; dt < 4; ++dt)
#pragma unroll
        for (int i = 0; i < 16; ++i) st.acc[dt][i] = 0.f;
}

DI void nsa_item(const Params& P, LAS unsigned char* wl, int b, int g, int t0, int lane_in) {
    const int lane = opaque_i(lane_in);
    const int l32 = lane & 31, hh = lane >> 5; const int tki = l32 >> 3, head = g * 8 + (l32 & 7); const int tq = t0 + tki;
    const unsigned tok = (unsigned)(b * TT + tq); const unsigned poff = tok * (unsigned)LDP; const unsigned ooff = tok * 4096u + 2048u + (unsigned)head * 128u;
    bf16x8 qf[8];
    {
        float qv[64]; float s = 0.f;
#pragma unroll
        for (int ks = 0; ks < 8; ++ks) { const u32x4 a = *(const u32x4*)(P_proj + (poff + C_Q + head * 128 + 16 * ks + 8 * hh)); const unsigned uw[4] = {a.x, a.y, a.z, a.w};
#pragma unroll
            for (int j = 0; j < 4; ++j) { const float v0 = lo16(uw[j]), v1 = hi16(uw[j]); qv[8 * ks + 2 * j] = v0; qv[8 * ks + 2 * j + 1] = v1; s += v0 * v0 + v1 * v1; } }
        s += __shfl_xor(s, 32);
        const float rstd = 1.f / sqrtf(s * (1.f / 128.f) + EPSF);
#pragma unroll
        for (int ks = 0; ks < 8; ++ks) { const f32x4 w0 = *(const f32x4*)(P.q_norm_w + 16 * ks + 8 * hh), w1 = *(const f32x4*)(P.q_norm_w + 16 * ks + 8 * hh + 4);
            u32x4 o; o.x = pk2(qv[8 * ks + 0] * rstd * w0[0], qv[8 * ks + 1] * rstd * w0[1]); o.y = pk2(qv[8 * ks + 2] * rstd * w0[2], qv[8 * ks + 3] * rstd * w0[3]);
            o.z = pk2(qv[8 * ks + 4] * rstd * w1[0], qv[8 * ks + 5] * rstd * w1[1]); o.w = pk2(qv[8 * ks + 6] * rstd * w1[2], qv[8 * ks + 7] * rstd * w1[3]);
            qf[ks] = __builtin_bit_cast(bf16x8, o); }
    }
    AttnState st;
    const bf16_t* kcb = P_kc + (size_t)(b * 2 + g) * 128 * 128; const bf16_t* vcb = P_vcT + (size_t)(b * 2 + g) * 128 * 128;
    const int ncv = (t0 + 3 >= 31) ? ((t0 + 3 - 31) >> 4) + 1 : 0;
    const int nct = (ncv + 31) >> 5;
    attn_reset(st);
    for (int kt = 0; kt < nct; ++kt) attn_tile<0>(wl, kcb, 128, vcb, 128, kt * 32, qf, st, tq, true, lane);
    {
        const float g0 = sigmoidf_(bf2f(P_proj[poff + C_GATE + head * 3 + 0]));
        const float inv = st.l > 0.f ? g0 / st.l : 0.f;
#pragma unroll
        for (int dt = 0; dt < 4; ++dt)
#pragma unroll
            for (int ig = 0; ig < 4; ++ig) { const int d0 = 32 * dt + 8 * ig + 4 * hh;
                u32x2 w; w.x = pk2(st.acc[dt][4 * ig] * inv, st.acc[dt][4 * ig + 1] * inv); w.y = pk2(st.acc[dt][4 * ig + 2] * inv, st.acc[dt][4 * ig + 3] * inv);
                *(u32x2*)(P_onsa + (ooff + d0)) = w; }
    }
    LAS float* psum = (LAS float*)(wl + NSA_V_OFF); LAS float* vals = (LAS float*)(wl + NSA_V_OFF + 2048);
    {
        const float invl = st.l > 0.f ? 1.f / st.l : 0.f; const float mfin = st.m;
        asm volatile("" ::: "memory");
        for (int i = lane; i < 512; i += 64) psum[i] = 0.f;
        LDS_FENCE();
        for (int kt = 0; kt < nct; ++kt) {
            LDS_FENCE();
            dma_k_tile(wl, kcb + (size_t)kt * 32 * 128, 256u, lane);
            asm volatile("s_waitcnt vmcnt(0)" ::: "memory");
            f32x16 S = qk_tile(wl, qf, lane);
#pragma unroll
            for (int i = 0; i < 16; ++i) { const int cidx = kt * 32 + crow(i, hh); const bool ok = (16 * cidx + 31 <= tq);
                float p = ok ? __builtin_amdgcn_exp2f(S[i] * SM_SCALE - mfin) * invl : 0.f;
                p += __shfl_xor(p, 1); p += __shfl_xor(p, 2); p += __shfl_xor(p, 4);
                if ((lane & 7) == 0) psum[tki * 128 + cidx] = p; }
            LDS_FENCE();
        }
    }
    unsigned selm[4];
#pragma unroll
    for (int tt = 0; tt < 2; ++tt) {
        const int tkn = 2 * tt + hh, j = l32; const int tqq = t0 + tkn, cur = tqq >> 6;
        float imp = 0.f;
#pragma unroll
        for (int c = -1; c < 4; ++c) { const int ci = 4 * j + c; if (ci >= 0) imp += psum[tkn * 128 + ci]; }
        const bool forced = (j == cur) || (j == 0), validb = (j <= cur);
        const unsigned key = forced ? 0x7f000000u : (validb ? (__float_as_uint(fmaxf(imp, 0.f)) + 1u) : 0u);
        ((LAS unsigned*)vals)[tkn * 32 + j] = key;
        LDS_FENCE();
        const unsigned long long kk = ((unsigned long long)key << 5) | (unsigned)(31 - j);
        int rank = 0;
#pragma unroll 4
        for (int jj = 0; jj < 32; ++jj) { const unsigned long long ko = ((unsigned long long)((LAS unsigned*)vals)[tkn * 32 + jj] << 5) | (unsigned)(31 - jj); rank += (ko > kk) ? 1 : 0; }
        const unsigned long long bal = __ballot(rank < 8);
        selm[2 * tt] = (unsigned)bal; selm[2 * tt + 1] = (unsigned)(bal >> 32);
    }
    LDS_FENCE();
    const unsigned mysel = tki == 0 ? selm[0] : (tki == 1 ? selm[1] : (tki == 2 ? selm[2] : selm[3]));
    {
        const int curb = t0 >> 6; const unsigned validm = (curb >= 31) ? 0xffffffffu : ((2u << curb) - 1u);
        unsigned U = (selm[0] | selm[1] | selm[2] | selm[3]) & validm;
        const bf16_t* kb = P_proj + (size_t)b * TT * LDP + C_KSLC + g * 128; const bf16_t* vb = P_vslcT + (size_t)(b * 2 + g) * 128 * TT;
        attn_reset(st);
        while (U) {
            const int j = __builtin_ctz(U); U &= U - 1u; const bool rs = (mysel >> j) & 1u;
            attn_tile<1>(wl, kb, LDP, vb, TT, 64 * j, qf, st, tq, rs, lane);
            if (64 * j + 32 <= t0 + 3) attn_tile<1>(wl, kb, LDP, vb, TT, 64 * j + 32, qf, st, tq, rs, lane);
        }
        const float g1 = sigmoidf_(bf2f(P_proj[poff + C_GATE + head * 3 + 1]));
        const float inv = st.l > 0.f ? g1 / st.l : 0.f;
#pragma unroll
        for (int dt = 0; dt < 4; ++dt)
#pragma unroll
            for (int ig = 0; ig < 4; ++ig) { const int d0 = 32 * dt + 8 * ig + 4 * hh; u32x2* op = (u32x2*)(P_onsa + (ooff + d0)); const u32x2 pv = *op;
                u32x2 w; w.x = pk2(lo16(pv.x) + st.acc[dt][4 * ig] * inv, hi16(pv.x) + st.acc[dt][4 * ig + 1] * inv); w.y = pk2(lo16(pv.y) + st.acc[dt][4 * ig + 2] * inv, hi16(pv.y) + st.acc[dt][4 * ig + 3] * inv);
                *op = w; }
    }
    {
        const bf16_t* kb = P_proj + (size_t)b * TT * LDP + C_KWIN + g * 128; const bf16_t* vb = P_vwinT + (size_t)(b * 2 + g) * 128 * TT;
        int lo = t0 - 511; if (lo < 0) lo = 0; lo &= ~31;
        attn_reset(st);
        for (int kb0 = lo; kb0 <= t0 + 3; kb0 += 32) attn_tile<2>(wl, kb, LDP, vb, TT, kb0, qf, st, tq, true, lane);
        const float g2 = sigmoidf_(bf2f(P_proj[poff + C_GATE + head * 3 + 2]));
        const float inv = st.l > 0.f ? g2 / st.l : 0.f;
#pragma unroll
        for (int dt = 0; dt < 4; ++dt)
#pragma unroll
            for (int i = 0; i < 16; ++i) st.acc[dt][i] *= inv;
    }
#pragma unroll
    for (int dt = 0; dt < 4; ++dt)
#pragma unroll
        for (int ig = 0; ig < 4; ++ig) { const int d0 = 32 * dt + 8 * ig + 4 * hh;
            const u32x2 zz = *(const u32x2*)(P_proj + (poff + C_ZNSA + head * 128 + d0));
            const u32x2 pv = *(const u32x2*)(P_onsa + (ooff + d0));
            const float o0 = st.acc[dt][4 * ig + 0] + lo16(pv.x), o1 = st.acc[dt][4 * ig + 1] + hi16(pv.x), o2 = st.acc[dt][4 * ig + 2] + lo16(pv.y), o3 = st.acc[dt][4 * ig + 3] + hi16(pv.y);
            u32x2 w; w.x = pk2(o0 * siluf_(lo16(zz.x)), o1 * siluf_(hi16(zz.x))); w.y = pk2(o2 * siluf_(lo16(zz.y)), o3 * siluf_(hi16(zz.y)));
            *(u32x2*)(P_onsa + (ooff + d0)) = w; }
}

constexpr int CO_RING = 0, CO_TOT = 65536, CO_SCR = 131072, CO_LIST = 151552, CO_UW = 152576;

DI void co_issue(const Params& P, LAS unsigned char* ring, int slot, unsigned desc, int b, int g, int wave, int lane) {
    const int mode = (int)(desc >> 16), key_base = (int)(desc & 0xffffu);
    const bf16_t* kb; const bf16_t* vb; unsigned ks_b, vs_b;
    if (mode <= 1) { kb = P_kc + (size_t)(b * 2 + g) * 128 * 128; ks_b = 256u; vb = P_vcT + (size_t)(b * 2 + g) * 128 * 128; vs_b = 256u; }
    else if (mode == 2) { kb = P_proj + (size_t)b * TT * LDP + C_KWIN + g * 128; ks_b = LDP * 2u; vb = P_vwinT + (size_t)(b * 2 + g) * 128 * TT; vs_b = TT * 2u; }
    else { kb = P_proj + (size_t)b * TT * LDP + C_KSLC + g * 128; ks_b = LDP * 2u; vb = P_vslcT + (size_t)(b * 2 + g) * 128 * TT; vs_b = TT * 2u; }
    LAS unsigned char* st = ring + slot * 16384;
    { const int rr = lane >> 4, c0 = (lane & 15) ^ rr; const unsigned voff = (unsigned)rr * ks_b + (unsigned)((c0 ^ ((4 * wave) & 15)) * 16);
      const char* ub = (const char*)kb + (size_t)(key_base + 4 * wave) * ks_b;
      __builtin_amdgcn_global_load_lds((const unsigned*)(ub + voff), (LAS unsigned*)(st + wave * 1024), 16, 0, 0); }
    { const int dr = lane >> 2, vpos = lane & 3; const unsigned voff = (unsigned)dr * vs_b + (unsigned)((vpos ^ ((dr >> 2) & 3)) * 16);
      const char* ub = (const char*)vb + (size_t)(16 * wave) * vs_b + (size_t)key_base * 2;
      __builtin_amdgcn_global_load_lds((const unsigned*)(ub + voff), (LAS unsigned*)(st + 8192 + wave * 1024), 16, 0, 0); }
}

DI f32x16 co_qk(LAS unsigned char* st, const bf16x8 (&qf)[8], int ka) {
    f32x16 S0, S1;
#pragma unroll
    for (int i = 0; i < 16; ++i) { S0[i] = 0.f; S1[i] = 0.f; }
#pragma unroll
    for (int ks = 0; ks < 8; ks += 2) {
        const bf16x8 a0 = *(const LAS bf16x8*)(st + (ka ^ (32 * ks)));
        const bf16x8 a1 = *(const LAS bf16x8*)(st + (ka ^ (32 * ks + 32)));
        S0 = MFMA32(a0, qf[ks], S0); S1 = MFMA32(a1, qf[ks + 1], S1); }
#pragma unroll
    for (int i = 0; i < 16; ++i) S0[i] += S1[i];
    return S0;
}

template <int MODE, bool FULL>
DI void co_tile(LAS unsigned char* st, int key_base, const bf16x8 (&qf)[8], AttnState& as, int tq, bool rowsel, int ka_in, int vb_in, int hh) {
    const int ka = opaque_i(ka_in), vb = opaque_i(vb_in);
    f32x16 S = co_qk(st, qf, ka);
    if (!FULL) {
        const int base = key_base + 4 * hh;
        const int hi = (MODE == 0) ? (((tq - 31) >> 4) - base) : (tq - base);
        const int lo = hi - 512;
#pragma unroll
        for (int i = 0; i < 16; ++i) { const int c = (i & 3) + 8 * (i >> 2); bool ok = (c <= hi); if (MODE == 2) ok = ok && (c > lo); S[i] = ok ? S[i] : -1e30f; }
    }
    if (MODE == 1) {
#pragma unroll
        for (int i = 0; i < 16; ++i) S[i] = rowsel ? S[i] : -1e30f;
    }
    float mx = S[0];
#pragma unroll
    for (int i = 1; i < 16; ++i) mx = fmaxf(mx, S[i]);
    mx = xh_max(mx);
    const float mxs = mx * SM_SCALE; const bool need = mxs > as.m + 8.f;
    const float mnew = need ? mxs : as.m, muse = -fmaxf(mnew, -1e20f); float ps = 0.f;
#pragma unroll
    for (int i = 0; i < 16; ++i) { const float p = __builtin_amdgcn_exp2f(__builtin_fmaf(S[i], SM_SCALE, muse)); S[i] = p; ps += p; }
    ps = xh_sum(ps);
    if (__builtin_amdgcn_ballot_w64(need) != 0ull) {
        const float alpha = __builtin_amdgcn_exp2f(as.m - mnew);
        as.l *= alpha;
#pragma unroll
        for (int dt = 0; dt < 4; ++dt)
#pragma unroll
            for (int i = 0; i < 16; ++i) as.acc[dt][i] *= alpha;
    }
    as.l += ps; as.m = mnew;
    const bf16x8 p0 = pack8(S, 0), p1 = pack8(S, 1);
#pragma unroll
    for (int dt = 0; dt < 4; ++dt) {
        LAS unsigned char* vp = st + 2048 * dt;
        const bf16x8 a0 = cat44(*(const LAS s16x4*)(vp + (vb ^ 0)), *(const LAS s16x4*)(vp + (vb ^ 16))), a1 = cat44(*(const LAS s16x4*)(vp + (vb ^ 32)), *(const LAS s16x4*)(vp + (vb ^ 48)));
        as.acc[dt] = MFMA32(a0, p0, as.acc[dt]); as.acc[dt] = MFMA32(a1, p1, as.acc[dt]);
    }
}

DI f32x16 co_qk1(LAS unsigned char* st, const bf16x8 (&qf)[8], int ka_in) {
    const int ka = ka_in;
    f32x16 S;
#pragma unroll
    for (int i = 0; i < 16; ++i) S[i] = 0.f;
    __builtin_amdgcn_s_setprio(1);
#pragma unroll
    for (int ks = 0; ks < 8; ++ks) { const bf16x8 a = *(const LAS bf16x8*)(st + (ka ^ (32 * ks))); S = MFMA32(a, qf[ks], S); }
    __builtin_amdgcn_s_setprio(0);
    return S;
}
template <int MODE>
DI void co_finish(f32x16 S, LAS unsigned char* st, int key_base, AttnState& as, int tq, bool rowsel, int vb_in, int hh) {
    const int vb = vb_in;
    {
        const int base = key_base + 4 * hh;
        const int hi = (MODE == 0) ? (((tq - 31) >> 4) - base) : (tq - base);
        const int lo = hi - 512;
#pragma unroll
        for (int i = 0; i < 16; ++i) { const int c = (i & 3) + 8 * (i >> 2); bool ok = (c <= hi); if (MODE == 2) ok = ok && (c > lo); if (MODE == 1) ok = ok && rowsel; S[i] = ok ? S[i] : -1e30f; }
    }
    float mx = S[0];
#pragma unroll
    for (int i = 1; i < 16; ++i) mx = fmaxf(mx, S[i]);
    mx = xh_max(mx);
    const float mxs = mx * SM_SCALE; const bool need = mxs > as.m + 8.f;
    const float mnew = need ? mxs : as.m, muse = -fmaxf(mnew, -1e20f); float ps = 0.f;
#pragma unroll
    for (int i = 0; i < 16; ++i) { const float p = __builtin_amdgcn_exp2f(__builtin_fmaf(S[i], SM_SCALE, muse)); S[i] = p; ps += p; }
    ps = xh_sum(ps);
    if (__builtin_amdgcn_ballot_w64(need) != 0ull) {
        const float alpha = __builtin_amdgcn_exp2f(as.m - mnew);
        as.l *= alpha;
#pragma unroll
        for (int dt = 0; dt < 4; ++dt)
#pragma unroll
            for (int i = 0; i < 16; ++i) as.acc[dt][i] *= alpha;
    }
    as.l += ps; as.m = mnew;
    const bf16x8 p0 = pack8(S, 0), p1 = pack8(S, 1);
    __builtin_amdgcn_s_setprio(1);
#pragma unroll
    for (int dt = 0; dt < 4; ++dt) {
        LAS unsigned char* vp = st + 2048 * dt;
        const bf16x8 a0 = cat44(*(const LAS s16x4*)(vp + (vb ^ 0)), *(const LAS s16x4*)(vp + (vb ^ 16))), a1 = cat44(*(const LAS s16x4*)(vp + (vb ^ 32)), *(const LAS s16x4*)(vp + (vb ^ 48)));
        as.acc[dt] = MFMA32(a0, p0, as.acc[dt]); as.acc[dt] = MFMA32(a1, p1, as.acc[dt]);
    }
    __builtin_amdgcn_s_setprio(0);
}
#define CO_STEP2(list, n, i) do { \
    if ((n) - 1 - (i) >= 1) asm volatile("s_waitcnt vmcnt(2)" ::: "memory"); else asm volatile("s_waitcnt vmcnt(0)" ::: "memory"); \
    asm volatile("s_waitcnt lgkmcnt(0)" ::: "memory"); __builtin_amdgcn_s_barrier(); asm volatile("" ::: "memory"); \
    if ((i) + 2 < (n)) co_issue(P, ring, ((i) + 2) & 3, (list)[(i) + 2], b, g, wave, lane); } while (0)
#define CO_PIPE(MODE, REL, KB, RS) do { const bool rel_ = (REL); LAS unsigned char* sp_ = ring + (i & 3) * 16384; f32x16 Sn_; \
    if (rel_) Sn_ = co_qk1(sp_, qf, ka); \
    if (pend) co_finish<MODE>(Sp, pst, pkb, st, tq, prs, vb, hh); \
    pend = rel_; if (rel_) { Sp = Sn_; pst = sp_; pkb = (KB); prs = (RS); } } while (0)
#define CO_DRAIN(MODE) do { if (pend) { co_finish<MODE>(Sp, pst, pkb, st, tq, prs, vb, hh); pend = false; } } while (0)

#define CO_STEP(list, n, i) do { const int rem_ = (n) - 1 - (i); \
    if (rem_ >= 2) asm volatile("s_waitcnt vmcnt(4)" ::: "memory"); else if (rem_ == 1) asm volatile("s_waitcnt vmcnt(2)" ::: "memory"); else asm volatile("s_waitcnt vmcnt(0)" ::: "memory"); \
    asm volatile("s_waitcnt lgkmcnt(0)" ::: "memory"); __builtin_amdgcn_s_barrier(); asm volatile("" ::: "memory"); \
    if ((i) + 3 < (n)) co_issue(P, ring, ((i) + 3) & 3, (list)[(i) + 3], b, g, wave, lane); } while (0)
#define CO_BAR() do { asm volatile("s_waitcnt lgkmcnt(0)" ::: "memory"); __builtin_amdgcn_s_barrier(); asm volatile("" ::: "memory"); } while (0)

DI void nsa_block_item(const Params& P, unsigned char* smem_g, int b, int g, int tb, int tid_in) {
    LAS unsigned char* sm = (LAS unsigned char*)smem_g;
    const int tid = opaque_i(tid_in), lane = tid & 63, wave = __builtin_amdgcn_readfirstlane(tid >> 6);
    const int l32 = lane & 31, hh = lane >> 5; const int tki = l32 >> 3, head = g * 8 + (l32 & 7);
    const int t0b = tb * 32, t0 = t0b + 4 * wave, tq = t0 + tki;
    const unsigned tok = (unsigned)(b * TT + tq); const unsigned poff = tok * (unsigned)LDP; const unsigned ooff = tok * 4096u + 2048u + (unsigned)head * 128u;
    const int ka = l32 * 256 + 16 * (hh ^ (l32 & 15)), vb = 8192 + l32 * 64 + 8 * hh + 16 * ((l32 >> 2) & 3);
    LAS unsigned char* ring = sm + CO_RING; LAS u32x2* totw = (LAS u32x2*)(sm + CO_TOT + wave * 8192);
    LAS float* psum = (LAS float*)(sm + CO_SCR + wave * 2560); LAS unsigned* vals = (LAS unsigned*)(sm + CO_SCR + wave * 2560 + 2048);
    LAS unsigned* list1 = (LAS unsigned*)(sm + CO_LIST); LAS unsigned* list2 = list1 + 32; LAS unsigned* uw = (LAS unsigned*)(sm + CO_UW);
    bf16x8 qf[8];
    {
        float qv[64]; float s = 0.f;
#pragma unroll
        for (int ks = 0; ks < 8; ++ks) { const u32x4 a = *(const u32x4*)(P_proj + (poff + C_Q + head * 128 + 16 * ks + 8 * hh)); const unsigned uw4[4] = {a.x, a.y, a.z, a.w};
#pragma unroll
            for (int j = 0; j < 4; ++j) { const float v0 = lo16(uw4[j]), v1 = hi16(uw4[j]); qv[8 * ks + 2 * j] = v0; qv[8 * ks + 2 * j + 1] = v1; s += v0 * v0 + v1 * v1; } }
        s += __shfl_xor(s, 32);
        const float rstd = 1.f / sqrtf(s * (1.f / 128.f) + EPSF);
#pragma unroll
        for (int ks = 0; ks < 8; ++ks) { const f32x4 w0 = *(const f32x4*)(P.q_norm_w + 16 * ks + 8 * hh), w1 = *(const f32x4*)(P.q_norm_w + 16 * ks + 8 * hh + 4);
            u32x4 o; o.x = pk2(qv[8 * ks + 0] * rstd * w0[0], qv[8 * ks + 1] * rstd * w0[1]); o.y = pk2(qv[8 * ks + 2] * rstd * w0[2], qv[8 * ks + 3] * rstd * w0[3]);
            o.z = pk2(qv[8 * ks + 4] * rstd * w1[0], qv[8 * ks + 5] * rstd * w1[1]); o.w = pk2(qv[8 * ks + 6] * rstd * w1[2], qv[8 * ks + 7] * rstd * w1[3]);
            qf[ks] = __builtin_bit_cast(bf16x8, o); }
    }
    const float g0 = sigmoidf_(bf2f(P_proj[poff + C_GATE + head * 3 + 0])), g1 = sigmoidf_(bf2f(P_proj[poff + C_GATE + head * 3 + 1])), g2 = sigmoidf_(bf2f(P_proj[poff + C_GATE + head * 3 + 2]));
    const int nA = (((t0b >> 4) + 1) + 31) >> 5;
    int lo = t0b - 511; if (lo < 0) lo = 0; lo &= ~31;
    const int nD = ((t0b - lo) >> 5) + 1, n1 = 2 * nA + nD;
    asm volatile("s_waitcnt vmcnt(0)" ::: "memory");
    CO_BAR();
    if (tid < n1) { const unsigned d = tid < nA ? (unsigned)(tid * 32) : (tid < 2 * nA ? ((1u << 16) | (unsigned)((tid - nA) * 32)) : ((2u << 16) | (unsigned)(lo + (tid - 2 * nA) * 32))); list1[tid] = d; }
    CO_BAR();
    AttnState st;
    bool pend = false, prs = false; f32x16 Sp; int pkb = 0; LAS unsigned char* pst = ring;
#pragma unroll
    for (int i2 = 0; i2 < 16; ++i2) Sp[i2] = 0.f;
#pragma unroll
    for (int s = 0; s < 2; ++s) if (s < n1) co_issue(P, ring, s, list1[s], b, g, wave, lane);
    int i = 0;
    attn_reset(st);
    for (; i < nA; ++i) { CO_STEP2(list1, n1, i); const int kb_ = 32 * i; CO_PIPE(0, 16 * kb_ + 31 <= t0 + 3, kb_, true); }
    CO_DRAIN(0);
    {
        const float inv = st.l > 0.f ? g0 / st.l : 0.f;
#pragma unroll
        for (int dt = 0; dt < 4; ++dt)
#pragma unroll
            for (int ig = 0; ig < 4; ++ig) { u32x2 w; w.x = pk2(st.acc[dt][4 * ig] * inv, st.acc[dt][4 * ig + 1] * inv); w.y = pk2(st.acc[dt][4 * ig + 2] * inv, st.acc[dt][4 * ig + 3] * inv); totw[(dt * 4 + ig) * 64 + lane] = w; }
    }
    {
        const float invl = st.l > 0.f ? 1.f / st.l : 0.f; const float mfin = st.m;
        for (int k = lane; k < 512; k += 64) psum[k] = 0.f;
        for (; i < 2 * nA; ++i) {
            CO_STEP2(list1, n1, i); const int kb_ = 32 * (i - nA);
            if (16 * kb_ + 31 <= t0 + 3) {
                f32x16 S = co_qk(ring + (i & 3) * 16384, qf, ka);
#pragma unroll
                for (int r = 0; r < 16; ++r) { const int cidx = kb_ + crow(r, hh); const bool ok = (16 * cidx + 31 <= tq);
                    float p = ok ? __builtin_amdgcn_exp2f(S[r] * SM_SCALE - mfin) * invl : 0.f;
                    p += __shfl_xor(p, 1); p += __shfl_xor(p, 2); p += __shfl_xor(p, 4);
                    if ((lane & 7) == 0) psum[tki * 128 + cidx] = p; }
            }
        }
    }
    LDS_FENCE();
    unsigned selm[4];
#pragma unroll
    for (int tt = 0; tt < 2; ++tt) {
        const int tkn = 2 * tt + hh, j = l32; const int tqq = t0 + tkn, cur = tqq >> 6;
        float imp = 0.f;
#pragma unroll
        for (int c = -1; c < 4; ++c) { const int ci = 4 * j + c; if (ci >= 0) imp += psum[tkn * 128 + ci]; }
        const bool forced = (j == cur) || (j == 0), validb = (j <= cur);
        const unsigned key = forced ? 0x7f000000u : (validb ? (__float_as_uint(fmaxf(imp, 0.f)) + 1u) : 0u);
        vals[tkn * 32 + j] = key;
        LDS_FENCE();
        const unsigned long long kk = ((unsigned long long)key << 5) | (unsigned)(31 - j);
        int rank = 0;
#pragma unroll 4
        for (int jj = 0; jj < 32; ++jj) { const unsigned long long ko = ((unsigned long long)vals[tkn * 32 + jj] << 5) | (unsigned)(31 - jj); rank += (ko > kk) ? 1 : 0; }
        const unsigned long long bal = __ballot(rank < 8);
        selm[2 * tt] = (unsigned)bal; selm[2 * tt + 1] = (unsigned)(bal >> 32);
    }
    const unsigned mysel = tki == 0 ? selm[0] : (tki == 1 ? selm[1] : (tki == 2 ? selm[2] : selm[3]));
    const int curw = t0 >> 6; const unsigned validw = (curw >= 31) ? 0xffffffffu : ((2u << curw) - 1u);
    const unsigned Uw = (unsigned)__builtin_amdgcn_readfirstlane((int)((selm[0] | selm[1] | selm[2] | selm[3]) & validw));
    if (lane == 0) uw[wave] = Uw;
    attn_reset(st);
    for (; i < n1; ++i) { CO_STEP2(list1, n1, i); const int kb_ = lo + 32 * (i - 2 * nA); CO_PIPE(2, kb_ + 31 >= t0 - 511 && kb_ <= t0 + 3, kb_, true); }
    CO_DRAIN(2);
    {
        const float inv = st.l > 0.f ? g2 / st.l : 0.f;
#pragma unroll
        for (int dt = 0; dt < 4; ++dt)
#pragma unroll
            for (int ig = 0; ig < 4; ++ig) { const u32x2 pv = totw[(dt * 4 + ig) * 64 + lane];
                u32x2 w; w.x = pk2(lo16(pv.x) + st.acc[dt][4 * ig] * inv, hi16(pv.x) + st.acc[dt][4 * ig + 1] * inv); w.y = pk2(lo16(pv.y) + st.acc[dt][4 * ig + 2] * inv, hi16(pv.y) + st.acc[dt][4 * ig + 3] * inv);
                totw[(dt * 4 + ig) * 64 + lane] = w; }
    }
    CO_BAR();
    unsigned Ub = 0u;
#pragma unroll
    for (int w = 0; w < 8; ++w) Ub |= uw[w];
    Ub = (unsigned)__builtin_amdgcn_readfirstlane((int)Ub);
    const int curb = t0b >> 6; const bool last_single = ((t0b & 32) == 0);
    const int n2 = 2 * __builtin_popcount(Ub) - (last_single ? 1 : 0);
    if (tid < 32 && ((Ub >> tid) & 1u)) { const int pos = 2 * __builtin_popcount(Ub & ((1u << tid) - 1u)); list2[pos] = (3u << 16) | (unsigned)(64 * tid); if (!(tid == curb && last_single)) list2[pos + 1] = (3u << 16) | (unsigned)(64 * tid + 32); }
    CO_BAR();
#pragma unroll
    for (int s = 0; s < 2; ++s) if (s < n2) co_issue(P, ring, s, list2[s], b, g, wave, lane);
    attn_reset(st);
    for (i = 0; i < n2; ++i) {
        CO_STEP2(list2, n2, i); const int kb_ = (int)(list2[i] & 0xffffu); const int j = kb_ >> 6;
        CO_PIPE(1, ((Uw >> j) & 1u) && kb_ <= t0 + 3, kb_, (bool)((mysel >> j) & 1u));
    }
    CO_DRAIN(1);
    {
        const int lane2 = opaque_i(lane); const int hh = lane2 >> 5, head = g * 8 + (lane2 & 7); const unsigned tok = (unsigned)(b * TT + t0 + ((lane2 & 31) >> 3));
        const unsigned poff = tok * (unsigned)LDP, ooff = tok * 4096u + 2048u + (unsigned)head * 128u;
        const float inv = st.l > 0.f ? g1 / st.l : 0.f;
#pragma unroll
        for (int dt = 0; dt < 4; ++dt)
#pragma unroll
            for (int ig = 0; ig < 4; ++ig) { const int d0 = 32 * dt + 8 * ig + 4 * hh;
                const u32x2 zz = *(const u32x2*)(P_proj + (poff + C_ZNSA + head * 128 + d0)); const u32x2 pv = totw[(dt * 4 + ig) * 64 + lane];
                const float o0 = st.acc[dt][4 * ig + 0] * inv + lo16(pv.x), o1 = st.acc[dt][4 * ig + 1] * inv + hi16(pv.x), o2 = st.acc[dt][4 * ig + 2] * inv + lo16(pv.y), o3 = st.acc[dt][4 * ig + 3] * inv + hi16(pv.y);
                u32x2 w; w.x = pk2(o0 * siluf_(lo16(zz.x)), o1 * siluf_(hi16(zz.x))); w.y = pk2(o2 * siluf_(lo16(zz.y)), o3 * siluf_(hi16(zz.y)));
                *(u32x2*)(P_onsa + (ooff + d0)) = w; }
    }
}

#ifndef NSA_COOP
#define NSA_COOP 1
#endif
DI void phase_nsa(const Params& P, unsigned char* smem) {
    const int tid = opaque_tid(), lane = tid & 63, wave = __builtin_amdgcn_readfirstlane(tid >> 6);
    LAS unsigned char* wl = (LAS unsigned char*)smem + wave * NSA_WAVE_LDS;
    for (int tk = blockIdx.x * 512 + tid; tk < NTOK; tk += gridDim.x * 512) {
        const f32x4* pp = (const f32x4*)(P_part + (size_t)tk * 64); float s = 0.f;
#pragma unroll
        for (int j = 0; j < 16; ++j) { const f32x4 v = pp[j]; s += (v[0] + v[1]) + (v[2] + v[3]); }
        P_rstd[tk] = 1.f / sqrtf(s * (1.f / 2048.f) + EPSF);
    }
#if NSA_COOP
    __syncthreads();
    for (int id = blockIdx.x; id < 2048; id += gridDim.x) {
        const int bg = id & 31; int tb = id >> 5; if ((tb >> 3) & 1) tb = (tb & ~7) | (7 - (tb & 7));
        nsa_block_item(P, smem, bg >> 1, bg & 1, tb, tid);
    }
    (void)wl; (void)lane;
#else
    const int nw = gridDim.x * 8;
    for (int id = blockIdx.x * 8 + wave; id < 16384; id += nw) {
        const int bg = id & 31, t4 = id >> 5;
        nsa_item(P, wl, bg >> 1, bg & 1, t4 * 4, lane);
    }
#endif
}

#define XB_TMO      128
#define XB_XCNT(j)  (256  + 64 * (j))
#define XB_XSUB(j)  (1280 + 64 * (j))
#define XB_XGEN(j)  (2304 + 64 * (j))
#define XB_TOP      3328
#define XB_TOPGEN   3392
#define XCD_BAR_WORDS 3456
#define XB_SPIN_CAP (1u << 18)
DI unsigned xb_ld(unsigned* p)              { return __hip_atomic_load(p, __ATOMIC_RELAXED, __HIP_MEMORY_SCOPE_AGENT); }
DI unsigned xb_add(unsigned* p, unsigned v) { return __hip_atomic_fetch_add(p, v, __ATOMIC_RELAXED, __HIP_MEMORY_SCOPE_AGENT); }
DI unsigned xb_xcc_id() { return (unsigned)__builtin_amdgcn_s_getreg((3 << 11) | 20) & 0xFu; }
#define XB_SPIN(cond, bar) do { unsigned _sp = 0; while (cond) { __builtin_amdgcn_s_sleep(1); \
    if ((++_sp & 255u) == 0u) { if (xb_ld(&(bar)[XB_TMO])) break; if (_sp > XB_SPIN_CAP) { atomicAdd(&(bar)[XB_TMO], 1u); break; } } } } while (0)
struct XcdBarrier { unsigned* bar; unsigned x; volatile LAS unsigned* st; };
DI XcdBarrier xcd_barrier_post(unsigned* bar, volatile LAS unsigned* st) {
    XcdBarrier b; b.bar = bar; b.x = xb_xcc_id(); b.st = st;
    if (threadIdx.x == 0) (void)xb_add(&bar[XB_XCNT(b.x)], 1u);
    return b;
}
DI void xcd_barrier_complete(unsigned* bar, unsigned x, unsigned& nloc, unsigned& nx) {
    const unsigned G = gridDim.x * gridDim.y * gridDim.z;
    unsigned sum, cnt, mine, sp = 0u;
    for (;;) {
        sum = 0u; cnt = 0u; mine = 0u;
#pragma unroll
        for (unsigned j = 0; j < 16; ++j) { const unsigned c = xb_ld(&bar[XB_XCNT(j)]); sum += c; cnt += (c > 0u) ? 1u : 0u; mine = (j == x) ? c : mine; }
        if (sum == G) break;
        __builtin_amdgcn_s_sleep(1);
        if ((++sp & 255u) == 0u) { if (xb_ld(&bar[XB_TMO])) break; if (sp > XB_SPIN_CAP) { atomicAdd(&bar[XB_TMO], 1u); break; } }
    }
    nloc = mine > 0u ? mine : 1u; nx = cnt > 0u ? cnt : 1u;
}
DI void xcd_barrier(const XcdBarrier& b) {
    asm volatile("s_waitcnt vmcnt(0)" ::: "memory");
    __syncthreads();
    if (threadIdx.x == 0) {
        unsigned* bar = b.bar;
        __builtin_amdgcn_s_waitcnt(0);
        unsigned nloc = b.st[0], nx = b.st[1];
        if (nloc == 0u) { xcd_barrier_complete(bar, b.x, nloc, nx); b.st[0] = nloc; b.st[1] = nx; }
        const unsigned old = xb_add(&bar[XB_XSUB(b.x)], 1u);
        const unsigned gen = old / nloc;
        if (old + 1u == (gen + 1u) * nloc) {
            __builtin_amdgcn_fence(__ATOMIC_RELEASE, "agent");
            asm volatile("s_waitcnt vmcnt(0)" ::: "memory");
            const unsigned og = xb_add(&bar[XB_TOP], 1u);
            const unsigned tg = og / nx;
            if (og + 1u == (tg + 1u) * nx) xb_add(&bar[XB_TOPGEN], 1u);
            else XB_SPIN(xb_ld(&bar[XB_TOPGEN]) == tg, bar);
            __builtin_amdgcn_fence(__ATOMIC_ACQUIRE, "agent");
            xb_add(&bar[XB_XGEN(b.x)], 1u);
            asm volatile("s_waitcnt vmcnt(0)" ::: "memory");
        } else {
            XB_SPIN(xb_ld(&bar[XB_XGEN(b.x)]) == gen, bar);
            __builtin_amdgcn_fence(__ATOMIC_ACQUIRE, "agent");
            asm volatile("s_waitcnt vmcnt(0)" ::: "memory");
        }
    }
    __syncthreads();
}

template <int PH>
DI void run_phase(const Params& P, unsigned char* smem) {
    pg8::StaticOrder S;
    if constexpr (PH == 0) phase_prep(P, smem);
    else if constexpr (PH == 1) { pg8::Gemm gm{P_h, P_winT, NTOK, LDP, DM, DM, DM}; S.init(NTOK, LDP, gridDim.x, blockIdx.x); pg8::EpiProj E{P_proj, LDP}; pg8::gemm_phase((LAS unsigned char*)smem, gm, S, E); }
    else if constexpr (PH == 2) phase_mix(P, smem);
    else if constexpr (PH == 3) phase_nsa(P, smem);
    else if constexpr (PH == 4) {
        S.init(NTOK, DM, gridDim.x, blockIdx.x);
        pg8::Gemm gm{P_yg, P_wossdT, NTOK, DM, 4096, 4096, 4096}; pg8::EpiMergeF E{P_proj, P_rstd}; pg8::gemm_phase((LAS unsigned char*)smem, gm, S, E);
    }
    else if constexpr (PH == 6) phase_bcconv(P);
    else if constexpr (PH == 5) { pg8::Gemm gm{P_proj, P_woT, NTOK, DM, DM, LDP, DM}; S.init(NTOK, DM, gridDim.x, blockIdx.x); pg8::EpiOut E{P.out, P.x}; pg8::gemm_phase((LAS unsigned char*)smem, gm, S, E); }
}

template <int LO, int HI>
__global__ void __launch_bounds__(512) fwd_kernel(Params P) {
    extern __shared__ __attribute__((aligned(16))) unsigned char smem[];
    if constexpr (HI - LO > 1) {
        cg::grid_group grid = cg::this_grid();
        if (P.ws == nullptr) grid.sync();
        volatile LAS unsigned* xst = (volatile LAS unsigned*)((LAS unsigned char*)smem + (LDS_BYTES - 16));
        if (threadIdx.x == 0) { xst[0] = 0u; xst[1] = 0u; }
        __syncthreads();
        const XcdBarrier xb = xcd_barrier_post((unsigned*)(P.ws + WS_BAR), xst);
        run_phase<0>(P, smem); xcd_barrier(xb);
        run_phase<1>(P, smem); xcd_barrier(xb);
        run_phase<6>(P, smem); xcd_barrier(xb);
        run_phase<2>(P, smem); xcd_barrier(xb);
        run_phase<3>(P, smem); xcd_barrier(xb);
        run_phase<4>(P, smem); xcd_barrier(xb);
        run_phase<5>(P, smem);
    } else {
        run_phase<LO>(P, smem);
    }
}

template <class K> static int setup_kernel(K kern) {
    if (hipFuncSetAttribute((const void*)kern, hipFuncAttributeMaxDynamicSharedMemorySize, LDS_BYTES) != hipSuccess) { fprintf(stderr, "kernel_launch: hipFuncSetAttribute failed\n"); return -1; }
    return 0;
}

extern "C" void kernel_launch(void* const* d_in, const int* in_sizes, int n_in, void* d_out, int out_size, void* d_ws, size_t ws_size, hipStream_t stream) {
    static int grid = 0;
    if (grid == 0) {
        if (n_in != 24 || in_sizes[0] != NTOK * DM || out_size != NTOK * DM || ws_size < WS_END) {
            fprintf(stderr, "kernel_launch: unexpected shapes / workspace (n_in %d, ws %zu, need %zu); nothing launched\n", n_in, ws_size, (size_t)WS_END); grid = -1; return; }
        int dev = 0, cus = 0, per_cu = 0;
        (void)hipGetDevice(&dev); (void)hipDeviceGetAttribute(&cus, hipDeviceAttributeMultiprocessorCount, dev);
#if ONE_LAUNCH
        if (setup_kernel(fwd_kernel<0, 6>)) { grid = -1; return; }
        (void)hipOccupancyMaxActiveBlocksPerMultiprocessor(&per_cu, (const void*)fwd_kernel<0, 6>, 512, LDS_BYTES);
        if (per_cu < 1) fprintf(stderr, "kernel_launch: occupancy query says %d blocks per CU\n", per_cu);
#else
        if (setup_kernel(fwd_kernel<0, 1>) || setup_kernel(fwd_kernel<1, 2>) || setup_kernel(fwd_kernel<2, 3>) || setup_kernel(fwd_kernel<3, 4>) || setup_kernel(fwd_kernel<4, 5>) || setup_kernel(fwd_kernel<5, 6>)) { grid = -1; return; }
#endif
        (void)hipGetLastError();
        grid = cus * 1;
    }
    if (grid < 0) return;
    Params p{};
    const float** fp = (const float**)&p;
    for (int i = 0; i < 24; ++i) fp[i] = (const float*)d_in[i];
    p.out = (float*)d_out; p.ws = (unsigned char*)d_ws;
#if ONE_LAUNCH
    if (hipMemsetAsync((unsigned char*)d_ws + WS_BAR, 0, XCD_BAR_WORDS * 4, stream) != hipSuccess) { fprintf(stderr, "kernel_launch: hipMemsetAsync failed\n"); return; }
    void* args[] = {&p};
    hipError_t e = hipLaunchCooperativeKernel((const void*)fwd_kernel<0, 6>, dim3(grid), dim3(512), args, LDS_BYTES, stream);
    if (e != hipSuccess) fprintf(stderr, "cooperative launch failed: %s (grid %d)\n", hipGetErrorString(e), grid);
#else
    hipLaunchKernelGGL((fwd_kernel<0, 1>), dim3(grid), dim3(512), LDS_BYTES, stream, p);
    hipLaunchKernelGGL((fwd_kernel<1, 2>), dim3(grid), dim3(512), LDS_BYTES, stream, p);
    hipLaunchKernelGGL((fwd_kernel<2, 3>), dim3(grid), dim3(512), LDS_BYTES, stream, p);
    hipLaunchKernelGGL((fwd_kernel<3, 4>), dim3(grid), dim3(512), LDS_BYTES, stream, p);
    hipLaunchKernelGGL((fwd_kernel<4, 5>), dim3(grid), dim3(512), LDS_BYTES, stream, p);
    hipLaunchKernelGGL((fwd_kernel<5, 6>), dim3(grid), dim3(512), LDS_BYTES, stream, p);
#endif
}
```

```cpp
#include <hip/hip_runtime.h>
#include <hip/hip_cooperative_groups.h>
#include <cstdio>
namespace cg = cooperative_groups;

#ifndef PROBE_DUP
#define PROBE_DUP -1
#endif
#ifndef ONE_LAUNCH
#define ONE_LAUNCH 1
#endif

#define DI __device__ __forceinline__
#define LAS __attribute__((address_space(3)))
typedef unsigned short bf16_t;
typedef short bf16x8 __attribute__((ext_vector_type(8)));
typedef short s16x4 __attribute__((ext_vector_type(4)));
typedef float f32x4 __attribute__((ext_vector_type(4)));
typedef float f32x2 __attribute__((ext_vector_type(2)));
typedef float f32x16 __attribute__((ext_vector_type(16)));
typedef unsigned u32x4 __attribute__((ext_vector_type(4)));
typedef unsigned u32x2 __attribute__((ext_vector_type(2)));
typedef __bf16 bf16x2_t __attribute__((ext_vector_type(2)));

constexpr int NTOK = 32768, TT = 2048, DM = 2048, LDP = 15104, INDIM = 14928;
constexpr int C_Z = 0, C_X = 2048, C_BM = 4096, C_CM = 4608, C_Q = 5120, C_KCMP = 7168, C_VCMP = 7424, C_KSLC = 7680, C_VSLC = 7936,
              C_KWIN = 8192, C_VWIN = 8448, C_ZNSA = 8704, C_GLS = 10752, C_GLN = 12800, C_DT = 14848, C_GATE = 14880;
constexpr float EPSF = 1e-6f;
constexpr int LDS_BYTES = 160 * 1024;

constexpr size_t WS_PROJ = 0, SZ_PROJ = (size_t)NTOK * LDP * 2;
constexpr size_t WS_WINT = WS_PROJ + SZ_PROJ, SZ_WINT = (size_t)LDP * DM * 2;
constexpr size_t WS_WOSSD = WS_WINT, WS_WONSA = WS_WINT + 8388608, WS_WO = WS_WINT + 16777216, WS_VSLCT = WS_WINT + 25165824, WS_VWINT = WS_WINT + 41943040;
constexpr size_t WS_SPARE = WS_WINT + SZ_WINT;
constexpr size_t WS_W1KT = WS_SPARE, WS_W1VT = WS_SPARE + 1048576, WS_W2KT = WS_SPARE + 2097152, WS_W2VT = WS_SPARE + 2129920,
                 WS_BIASK = WS_SPARE + 2162688, WS_BIASV = WS_SPARE + 2166784, WS_KC = WS_SPARE + 2170880, WS_VCT = WS_SPARE + 3219456,
                 WS_PART = WS_SPARE + 4268032, WS_RSTD = WS_SPARE + 12656640, WS_BAR = WS_SPARE + 12787712, WS_END = WS_BAR + 16384;

struct ParamsK {
    const float *x, *norm_w, *w_in, *conv_w, *conv_b, *dt_bias, *a_log, *d_skip, *ssd_norm_w, *q_norm_w, *k_cmp_norm_w, *k_slc_norm_w, *k_win_norm_w,
        *cmp_pe_k, *cmp_w1_k, *cmp_b1_k, *cmp_w2_k, *cmp_pe_v, *cmp_w1_v, *cmp_b1_v, *cmp_w2_v, *w_out_ssd, *w_out_nsa, *w_o;
    float* out; unsigned char* ws;
};
#define WSP(T, off) ((T*)(P.ws + (off)))
#define P_proj   WSP(bf16_t, WS_PROJ)
#define P_winT   WSP(bf16_t, WS_WINT)
#define P_h      ((bf16_t*)P.out)
#define P_yg     ((bf16_t*)P.out)
#define P_onsa   ((bf16_t*)P.out)
#define P_wossdT WSP(bf16_t, WS_WOSSD)
#define P_wonsaT WSP(bf16_t, WS_WONSA)
#define P_woT    WSP(bf16_t, WS_WO)
#define P_vslcT  WSP(bf16_t, WS_VSLCT)
#define P_vwinT  WSP(bf16_t, WS_VWINT)
#define P_kc     WSP(bf16_t, WS_KC)
#define P_vcT    WSP(bf16_t, WS_VCT)
#define P_w1kT   WSP(bf16_t, WS_W1KT)
#define P_w1vT   WSP(bf16_t, WS_W1VT)
#define P_w2kT   WSP(bf16_t, WS_W2KT)
#define P_w2vT   WSP(bf16_t, WS_W2VT)
#define P_biask  WSP(float, WS_BIASK)
#define P_biasv  WSP(float, WS_BIASV)
#define P_part   WSP(float, WS_PART)
#define P_rstd   WSP(float, WS_RSTD)
typedef ParamsK Params;

DI float bf2f(bf16_t u) { return __uint_as_float(((unsigned)u) << 16); }
DI unsigned pk2(float lo, float hi) { f32x2 v = {lo, hi}; bf16x2_t b = __builtin_convertvector(v, bf16x2_t); return __builtin_bit_cast(unsigned, b); }
DI bf16_t f2bf(float f) { return (bf16_t)(pk2(f, 0.f) & 0xffffu); }
DI float lo16(unsigned u) { return __uint_as_float(u << 16); }
DI float hi16(unsigned u) { return __uint_as_float(u & 0xffff0000u); }
DI float sigmoidf_(float x) { return __builtin_amdgcn_rcpf(1.f + __expf(-x)); }
DI float siluf_(float x) { return x * __builtin_amdgcn_rcpf(1.f + __expf(-x)); }
DI float wave_sum(float v) {
#pragma unroll
    for (int o = 1; o < 64; o <<= 1) v += __shfl_xor(v, o);
    return v;
}
DI int opaque_tid() { int t = threadIdx.x; asm volatile("" : "+v"(t)); return t; }
DI int opaque_i(int v) { asm volatile("" : "+v"(v)); return v; }
DI float xh_max(float x) { const unsigned u = __float_as_uint(x); const auto r = __builtin_amdgcn_permlane32_swap(u, u, false, false); return fmaxf(__uint_as_float(r[0]), __uint_as_float(r[1])); }
DI float xh_sum(float x) { const unsigned u = __float_as_uint(x); const auto r = __builtin_amdgcn_permlane32_swap(u, u, false, false); return __uint_as_float(r[0]) + __uint_as_float(r[1]); }
DI float dpp_f(float x, const int ctrl_unused) { return x; }
template <int CTRL> DI float dppf(float x) { return __int_as_float(__builtin_amdgcn_update_dpp(0, __float_as_int(x), CTRL, 0xf, 0xf, true)); }
DI float sum8_dpp(float p) { p += dppf<0xB1>(p); p += dppf<0x4E>(p); p += dppf<0x141>(p); return p; }
DI int crow(int i, int h) { return (i & 3) + 8 * (i >> 2) + 4 * h; }
#define MFMA32(a, b, c) __builtin_amdgcn_mfma_f32_32x32x16_bf16((a), (b), (c), 0, 0, 0)
DI bf16x8 pack8(const f32x16& x, int s) {
    u32x4 p;
    p.x = pk2(x[8 * s + 0], x[8 * s + 1]); p.y = pk2(x[8 * s + 2], x[8 * s + 3]); p.z = pk2(x[8 * s + 4], x[8 * s + 5]); p.w = pk2(x[8 * s + 6], x[8 * s + 7]);
    return __builtin_bit_cast(bf16x8, p);
}
DI bf16x8 cat44(s16x4 a, s16x4 b) { return __builtin_shufflevector(a, b, 0, 1, 2, 3, 4, 5, 6, 7); }
#define LDS_FENCE() asm volatile("s_waitcnt lgkmcnt(0)" ::: "memory")
#define LDS_BAR() do { asm volatile("s_waitcnt lgkmcnt(0)" ::: "memory"); __builtin_amdgcn_s_barrier(); asm volatile("" ::: "memory"); } while (0)

namespace pg8 {
constexpr int BM = 256, BK = 64, HALF = 128, HTB = HALF * BK * 2, STAGE_BYTES = 8 * HTB, NXCD = 8, WGM = 8;
DI int lds_byte(int r, int c) { const int st = (r >> 4) * 2 + (c >> 5), rr = r & 15, cc = c & 31, ob = rr * 64 + cc * 2; return st * 1024 + (ob ^ (((ob >> 9) & 1) << 5)); }
DI void stage_rc(int b, int& R, int& C) { const int st = b / 1024, sb = b % 1024, swz = sb ^ (((sb >> 9) & 1) << 5); R = (st >> 1) * 16 + swz / 64; C = (st & 1) * 32 + (swz % 64) / 2; }
DI int perm32(int rho) { const int n = rho >> 4, i = rho & 15; return 8 * (i >> 2) + 4 * n + (i & 3); }
struct Unit { int pm, pn; };
struct Gemm { const bf16_t* A; const bf16_t* Bt; int M, N, K, lda, ldb; };
struct StaticOrder {
    int nM, nN, nwg, G, c;
    DI void init(int M, int N, int G_, int c_) { nM = M / BM; nN = N / BM; nwg = nM * nN; G = G_; c = c_; }
    DI bool next(int i, Unit& u) const {
        const long L = (long)i * G + c; if (L >= nwg) return false;
        int wgid = (int)L; { const int q = nwg / NXCD, r = nwg % NXCD, xcd = wgid % NXCD, off = wgid / NXCD; wgid = (xcd < r ? xcd * (q + 1) : r * (q + 1) + (xcd - r) * q) + off; }
        const int nig = WGM * nN, gid = wgid / nig, fm = gid * WGM, gsz = (nM - fm) < WGM ? (nM - fm) : WGM;
        u.pm = fm + ((wgid % nig) % gsz); u.pn = (wgid % nig) / gsz; return true;
    }
};

template <class Epi>
DI void gemm_phase(LAS unsigned char* lds, const Gemm g, const StaticOrder& S, const Epi& E) {
    const int tid = opaque_tid(), wid = __builtin_amdgcn_readfirstlane(tid >> 6), lane = tid & 63, wr = wid >> 2, wc = wid & 3, fr = lane & 15, fq = lane >> 4;
    const int K = g.K, nt = K / BK;
    unsigned voffA[2], voffB[2];
#pragma unroll
    for (int i = 0; i < 2; ++i) { int R, C; stage_rc(tid * 16 + i * 8192, R, C); const int Rb = Epi::PERM ? ((R & ~31) + perm32(R & 31)) : R;
        voffA[i] = (unsigned)(R * g.lda + C) * 2u; voffB[i] = (unsigned)(Rb * g.ldb + C) * 2u; }
    const size_t kstep = (size_t)(BK * 2);
    const size_t hstepA = (size_t)HALF * g.lda * 2, hstepB = (size_t)HALF * g.ldb * 2;
    const size_t tstepA = 2 * hstepA, tstepB = 2 * hstepB;
    const unsigned ldsw = (unsigned)wid * 1024u;
    const int aoff = lds_byte(wr * 64 + fr, fq * 8), boff = lds_byte(wc * 32 + fr, fq * 8);
#define PG8_SA(b, h) (((b) * 2 + (h)) * HTB)
#define PG8_SB(b, h) ((4 + (b) * 2 + (h)) * HTB)
#define PG8_STAGE(bufoff, gbase, voff) do { _Pragma("unroll") for (int _i = 0; _i < 2; ++_i) \
        __builtin_amdgcn_global_load_lds((const unsigned*)((const char*)(gbase) + (voff)[_i]), (LAS unsigned*)(lds + (bufoff) + ldsw + _i * 8192), 16, 0, 0); } while (0)
#define PG8_LDA(dst, b, h) do { _Pragma("unroll") for (int m = 0; m < 4; ++m) _Pragma("unroll") for (int k = 0; k < 2; ++k) dst[m][k] = *(const LAS bf16x8*)(lds + PG8_SA(b, h) + aoff + m * 2048 + k * 1024); } while (0)
#define PG8_LDB(dst, b, h) do { _Pragma("unroll") for (int n = 0; n < 2; ++n) _Pragma("unroll") for (int k = 0; k < 2; ++k) dst[n][k] = *(const LAS bf16x8*)(lds + PG8_SB(b, h) + boff + n * 2048 + k * 1024); } while (0)
#define PG8_MMA(ai, bj, At, Bt) do { __builtin_amdgcn_s_setprio(1); _Pragma("unroll") for (int m = 0; m < 4; ++m) _Pragma("unroll") for (int n = 0; n < 2; ++n) _Pragma("unroll") for (int k = 0; k < 2; ++k) \
        acc[ai][bj][m][n] = __builtin_amdgcn_mfma_f32_16x16x32_bf16(Bt[n][k], At[m][k], acc[ai][bj][m][n], 0, 0, 0); __builtin_amdgcn_s_setprio(0); } while (0)
#define PG8_WAIT_V(n) asm volatile("s_waitcnt vmcnt(" #n ")" ::: "memory")
#define PG8_WAIT_L(n) asm volatile("s_waitcnt lgkmcnt(" #n ")" ::: "memory")
#define PG8_BAR __builtin_amdgcn_s_barrier()
#define PG8_SCHED __builtin_amdgcn_sched_barrier(0)
    Unit cur, nxt; int ui = 0;
    if (!S.next(0, cur)) return;
    f32x4 acc[2][2][4][2];
#pragma unroll
    for (int a = 0; a < 2; ++a)
#pragma unroll
        for (int b = 0; b < 2; ++b)
#pragma unroll
            for (int m = 0; m < 4; ++m)
#pragma unroll
                for (int n = 0; n < 2; ++n) acc[a][b][m][n] = (f32x4){0.f, 0.f, 0.f, 0.f};
    bf16x8 At[4][2], B0[2][2], B1[2][2];
    const char* cA = (const char*)g.A + (size_t)cur.pm * tstepA; const char* cB = (const char*)g.Bt + (size_t)cur.pn * tstepB;
    PG8_STAGE(PG8_SB(0, 0), cB, voffB); PG8_STAGE(PG8_SA(0, 0), cA, voffA); PG8_STAGE(PG8_SB(0, 1), cB + hstepB, voffB); PG8_STAGE(PG8_SA(0, 1), cA + hstepA, voffA);
    if (wr == 1) PG8_BAR;
    PG8_WAIT_V(4); PG8_BAR;
    PG8_STAGE(PG8_SB(1, 0), cB + kstep, voffB); PG8_STAGE(PG8_SA(1, 0), cA + kstep, voffA); PG8_STAGE(PG8_SB(1, 1), cB + hstepB + kstep, voffB);
    PG8_WAIT_V(6); PG8_BAR;
    for (;;) {
        const bool has_next = S.next(ui + 1, nxt);
        const char* nA = has_next ? (const char*)g.A + (size_t)nxt.pm * tstepA : cA; const char* nB = has_next ? (const char*)g.Bt + (size_t)nxt.pn * tstepB : cB;
        for (int t = 0; t < nt; t += 2) {
            const bool last = (t == nt - 2);
            const char* a1 = cA + (size_t)(t + 1) * kstep;
            const char* a2 = last ? nA : cA + (size_t)(t + 2) * kstep; const char* b2 = last ? nB : cB + (size_t)(t + 2) * kstep;
            const char* a3 = a2 + kstep; const char* b3 = b2 + kstep;
            if constexpr (Epi::HAS_MID) { if (t == Epi::MID_T) E.mid(acc, cur, wr, wc, fr, fq); }
            PG8_LDB(B0, 0, 0); PG8_SCHED; PG8_LDA(At, 0, 0); PG8_STAGE(PG8_SA(1, 1), a1 + hstepA, voffA);
            PG8_WAIT_L(8); PG8_BAR; PG8_WAIT_L(0); PG8_MMA(0, 0, At, B0); PG8_BAR; PG8_SCHED;
            PG8_LDB(B1, 0, 1); PG8_STAGE(PG8_SB(0, 0), b2, voffB);
            PG8_BAR; PG8_WAIT_L(0); PG8_MMA(0, 1, At, B1); PG8_BAR;
            PG8_LDA(At, 0, 1); PG8_STAGE(PG8_SA(0, 0), a2, voffA);
            PG8_BAR; PG8_WAIT_L(0); PG8_MMA(1, 0, At, B0); PG8_BAR; PG8_SCHED;
            PG8_STAGE(PG8_SB(0, 1), b2 + hstepB, voffB);
            PG8_WAIT_V(6); PG8_BAR; PG8_MMA(1, 1, At, B1); PG8_BAR;
            PG8_LDB(B0, 1, 0); PG8_SCHED; PG8_LDA(At, 1, 0); PG8_STAGE(PG8_SA(0, 1), a2 + hstepA, voffA);
            PG8_WAIT_L(8); PG8_BAR; PG8_WAIT_L(0); PG8_MMA(0, 0, At, B0); PG8_BAR; PG8_SCHED;
            PG8_LDB(B1, 1, 1); PG8_STAGE(PG8_SB(1, 0), b3, voffB);
            PG8_BAR; PG8_WAIT_L(0); PG8_MMA(0, 1, At, B1); PG8_BAR;
            PG8_LDA(At, 1, 1); PG8_STAGE(PG8_SA(1, 0), a3, voffA);
            PG8_BAR; PG8_WAIT_L(0); PG8_MMA(1, 0, At, B0); PG8_BAR; PG8_SCHED;
            PG8_STAGE(PG8_SB(1, 1), b3 + hstepB, voffB);
            PG8_WAIT_V(6); PG8_BAR; PG8_MMA(1, 1, At, B1); PG8_BAR;
        }
        E(acc, cur, wr, wc, fr, fq);
        if (!has_next) break;
#pragma unroll
        for (int a = 0; a < 2; ++a)
#pragma unroll
            for (int b = 0; b < 2; ++b)
#pragma unroll
                for (int m = 0; m < 4; ++m)
#pragma unroll
                    for (int n = 0; n < 2; ++n) acc[a][b][m][n] = (f32x4){0.f, 0.f, 0.f, 0.f};
        cur = nxt; cA = nA; cB = nB; ++ui;
    }
    PG8_WAIT_V(0);
    if (wr == 0) PG8_BAR;
    PG8_BAR;
#undef PG8_SA
#undef PG8_SB
#undef PG8_STAGE
#undef PG8_LDA
#undef PG8_LDB
#undef PG8_MMA
#undef PG8_WAIT_V
#undef PG8_WAIT_L
#undef PG8_BAR
#undef PG8_SCHED
}

struct EpiProj {
    static constexpr bool PERM = true, HAS_MID = false; static constexpr int MID_T = -1;
    bf16_t* O; int ldc;
    DI void operator()(const f32x4 (&acc)[2][2][4][2], const Unit& u, int wr, int wc, int fr, int fq) const {
        const int row0 = u.pm * BM + wr * 64 + fr, col0 = u.pn * BM + wc * 32 + 8 * fq;
#pragma unroll
        for (int ai = 0; ai < 2; ++ai)
#pragma unroll
            for (int m = 0; m < 4; ++m) { bf16_t* rowp = O + (size_t)(row0 + ai * HALF + m * 16) * ldc + col0;
#pragma unroll
                for (int bj = 0; bj < 2; ++bj) { const f32x4 v0 = acc[ai][bj][m][0], v1 = acc[ai][bj][m][1];
                    u32x4 w; w.x = pk2(v0[0], v0[1]); w.y = pk2(v0[2], v0[3]); w.z = pk2(v1[0], v1[1]); w.w = pk2(v1[2], v1[3]);
                    *(u32x4*)(rowp + bj * HALF) = w; } }
    }
};
template <int MODE>
struct EpiMerge {
    static constexpr bool PERM = true, HAS_MID = false; static constexpr int MID_T = -1;
    bf16_t* P; const float* rstd;
    DI void operator()(const f32x4 (&acc)[2][2][4][2], const Unit& u, int wr, int wc, int fr, int fq) const {
        const int row0 = u.pm * BM + wr * 64 + fr, col0 = u.pn * BM + wc * 32 + 8 * fq;
#pragma unroll
        for (int ai = 0; ai < 2; ++ai)
#pragma unroll
            for (int m = 0; m < 4; ++m) { const int row = row0 + ai * HALF + m * 16; bf16_t* rowp = P + (size_t)row * LDP + col0;
                const float rs = (MODE == 0) ? rstd[row] : 1.f;
#pragma unroll
                for (int bj = 0; bj < 2; ++bj) { const f32x4 v0 = acc[ai][bj][m][0], v1 = acc[ai][bj][m][1];
                    const u32x4 gl = *(const u32x4*)(rowp + bj * HALF + (MODE == 0 ? C_GLS : C_GLN));
                    float o[8] = {v0[0], v0[1], v0[2], v0[3], v1[0], v1[1], v1[2], v1[3]};
                    const unsigned gw[4] = {gl.x, gl.y, gl.z, gl.w};
                    u32x4 prev = {0u, 0u, 0u, 0u};
                    if (MODE == 1) prev = *(const u32x4*)(rowp + bj * HALF);
                    const unsigned pw[4] = {prev.x, prev.y, prev.z, prev.w};
#pragma unroll
                    for (int j = 0; j < 4; ++j) {
                        o[2 * j] = o[2 * j] * rs * sigmoidf_(lo16(gw[j])) + (MODE == 1 ? lo16(pw[j]) : 0.f);
                        o[2 * j + 1] = o[2 * j + 1] * rs * sigmoidf_(hi16(gw[j])) + (MODE == 1 ? hi16(pw[j]) : 0.f); }
                    u32x4 w; w.x = pk2(o[0], o[1]); w.y = pk2(o[2], o[3]); w.z = pk2(o[4], o[5]); w.w = pk2(o[6], o[7]);
                    *(u32x4*)(rowp + bj * HALF) = w; asm volatile("" ::: "memory"); } }
    }
};
struct EpiMergeF {
    static constexpr bool PERM = true, HAS_MID = true; static constexpr int MID_T = 32;
    bf16_t* P; const float* rstd;
    DI void mid(f32x4 (&acc)[2][2][4][2], const Unit& u, int wr, int wc, int fr, int fq) const {
        const int row0 = opaque_i(u.pm * BM + wr * 64 + fr), col0 = opaque_i(u.pn * BM + wc * 32 + 8 * fq);
#pragma unroll
        for (int ai = 0; ai < 2; ++ai) {
            u32x4 gs[4][2], gn[4][2]; float rs[4];
#pragma unroll
            for (int m = 0; m < 4; ++m) { const int row = row0 + ai * HALF + m * 16; const bf16_t* rowp = P + (size_t)row * LDP + col0; rs[m] = rstd[row];
#pragma unroll
                for (int bj = 0; bj < 2; ++bj) { gs[m][bj] = *(const u32x4*)(rowp + bj * HALF + C_GLS); gn[m][bj] = *(const u32x4*)(rowp + bj * HALF + C_GLN); } }
#pragma unroll
            for (int m = 0; m < 4; ++m)
#pragma unroll
                for (int bj = 0; bj < 2; ++bj) {
                    const unsigned gsw[4] = {gs[m][bj].x, gs[m][bj].y, gs[m][bj].z, gs[m][bj].w}, gnw[4] = {gn[m][bj].x, gn[m][bj].y, gn[m][bj].z, gn[m][bj].w};
#pragma unroll
                    for (int j = 0; j < 4; ++j) {
                        const float r0 = rs[m] * (1.f + __expf(-lo16(gnw[j]))) * __builtin_amdgcn_rcpf(1.f + __expf(-lo16(gsw[j])));
                        const float r1 = rs[m] * (1.f + __expf(-hi16(gnw[j]))) * __builtin_amdgcn_rcpf(1.f + __expf(-hi16(gsw[j])));
                        acc[ai][bj][m][j >> 1][(j & 1) * 2] *= r0; acc[ai][bj][m][j >> 1][(j & 1) * 2 + 1] *= r1; } }
            asm volatile("" ::: "memory");
        }
    }
    DI void operator()(const f32x4 (&acc)[2][2][4][2], const Unit& u, int wr, int wc, int fr, int fq) const {
        const int row0 = u.pm * BM + wr * 64 + fr, col0 = u.pn * BM + wc * 32 + 8 * fq;
        u32x4 gn[2][4][2];
#pragma unroll
        for (int ai = 0; ai < 2; ++ai)
#pragma unroll
            for (int m = 0; m < 4; ++m) { const bf16_t* rowp = P + (size_t)(row0 + ai * HALF + m * 16) * LDP + col0;
#pragma unroll
                for (int bj = 0; bj < 2; ++bj) gn[ai][m][bj] = *(const u32x4*)(rowp + bj * HALF + C_GLN); }
#pragma unroll
        for (int ai = 0; ai < 2; ++ai)
#pragma unroll
            for (int m = 0; m < 4; ++m) { bf16_t* rowp = P + (size_t)(row0 + ai * HALF + m * 16) * LDP + col0;
#pragma unroll
                for (int bj = 0; bj < 2; ++bj) { const f32x4 v0 = acc[ai][bj][m][0], v1 = acc[ai][bj][m][1];
                    const unsigned gnw[4] = {gn[ai][m][bj].x, gn[ai][m][bj].y, gn[ai][m][bj].z, gn[ai][m][bj].w};
                    const float o[8] = {v0[0], v0[1], v0[2], v0[3], v1[0], v1[1], v1[2], v1[3]};
                    u32x4 w;
                    w.x = pk2(o[0] * sigmoidf_(lo16(gnw[0])), o[1] * sigmoidf_(hi16(gnw[0]))); w.y = pk2(o[2] * sigmoidf_(lo16(gnw[1])), o[3] * sigmoidf_(hi16(gnw[1])));
                    w.z = pk2(o[4] * sigmoidf_(lo16(gnw[2])), o[5] * sigmoidf_(hi16(gnw[2]))); w.w = pk2(o[6] * sigmoidf_(lo16(gnw[3])), o[7] * sigmoidf_(hi16(gnw[3])));
                    *(u32x4*)(rowp + bj * HALF) = w; } }
    }
};
struct EpiOut {
    static constexpr bool PERM = false, HAS_MID = false; static constexpr int MID_T = -1;
    float* C; const float* X;
    DI void operator()(const f32x4 (&acc)[2][2][4][2], const Unit& u, int wr, int wc, int fr, int fq) const {
        const int row0 = u.pm * BM + wr * 64 + fr, col0 = u.pn * BM + wc * 32 + 4 * fq;
#pragma unroll
        for (int ai = 0; ai < 2; ++ai) {
            f32x4 xv[4][2][2];
#pragma unroll
            for (int m = 0; m < 4; ++m) { const size_t off = (size_t)(row0 + ai * HALF + m * 16) * DM + col0;
#pragma unroll
                for (int bj = 0; bj < 2; ++bj)
#pragma unroll
                    for (int n = 0; n < 2; ++n) xv[m][bj][n] = *(const f32x4*)(X + off + bj * HALF + n * 16); }
#pragma unroll
            for (int m = 0; m < 4; ++m) { const size_t off = (size_t)(row0 + ai * HALF + m * 16) * DM + col0;
#pragma unroll
                for (int bj = 0; bj < 2; ++bj)
#pragma unroll
                    for (int n = 0; n < 2; ++n) *(f32x4*)(C + off + bj * HALF + n * 16) = acc[ai][bj][m][n] + xv[m][bj][n]; }
            asm volatile("" ::: "memory");
        }
    }
};
}

DI int win_srccol(int j) {
    if (j < 5120) return j;
    if (j < 10752) return j + 32;
    if (j < 14848) return j + 80;
    if (j < 14880) return j - 14848 + 5120;
    if (j < 14928) return j - 14880 + 10784;
    return -1;
}
DI void transpose_tile(const float* src, int ldsrc, bf16_t* dst, int lddst, int k0, int n0, int mode, const float* rowscale, float* tile) {
    const int tid = opaque_tid();
    {
        const int r = tid >> 4, c4 = (tid & 15) * 4;
#pragma unroll
        for (int q = 0; q < 2; ++q) {
            const int rr = r + 32 * q; const int jd = n0 + c4; const int js = mode ? win_srccol(jd) : jd;
            f32x4 v = {0.f, 0.f, 0.f, 0.f};
            if (js >= 0) v = *(const f32x4*)(src + (size_t)(k0 + rr) * ldsrc + js);
            if (rowscale) { const float sc = rowscale[k0 + rr]; v = v * sc; }
            tile[rr * 65 + c4 + 0] = v[0]; tile[rr * 65 + c4 + 1] = v[1]; tile[rr * 65 + c4 + 2] = v[2]; tile[rr * 65 + c4 + 3] = v[3];
        }
    }
    LDS_BAR();
    {
        const int n = tid >> 3, k8 = (tid & 7) * 8;
        u32x4 w;
        w.x = pk2(tile[(k8 + 0) * 65 + n], tile[(k8 + 1) * 65 + n]); w.y = pk2(tile[(k8 + 2) * 65 + n], tile[(k8 + 3) * 65 + n]);
        w.z = pk2(tile[(k8 + 4) * 65 + n], tile[(k8 + 5) * 65 + n]); w.w = pk2(tile[(k8 + 6) * 65 + n], tile[(k8 + 7) * 65 + n]);
        *(u32x4*)(dst + (size_t)(n0 + n) * lddst + k0 + k8) = w;
    }
    LDS_BAR();
}

DI void phase_prep(const Params& P, unsigned char* smem) {
    const int tid = opaque_tid(), lane = tid & 63, wave = tid >> 6;
    for (int row = blockIdx.x * 8 + wave; row < NTOK; row += gridDim.x * 8) {
        const f32x4* xr = (const f32x4*)(P.x + (size_t)row * DM);
        f32x4 v[8]; float s = 0.f;
#pragma unroll
        for (int j = 0; j < 8; ++j) { v[j] = xr[lane + 64 * j]; s += v[j][0] * v[j][0] + v[j][1] * v[j][1] + v[j][2] * v[j][2] + v[j][3] * v[j][3]; }
        s = wave_sum(s);
        const float rstd = 1.f / sqrtf(s * (1.f / DM) + EPSF);
        u32x2* o = (u32x2*)(P_h + (size_t)row * DM);
#pragma unroll
        for (int j = 0; j < 8; ++j) { const f32x4 w = ((const f32x4*)P.norm_w)[lane + 64 * j]; u32x2 r; r.x = pk2(v[j][0] * rstd * w[0], v[j][1] * rstd * w[1]); r.y = pk2(v[j][2] * rstd * w[2], v[j][3] * rstd * w[3]); o[lane + 64 * j] = r; }
    }
    float* tile = (float*)smem;
    constexpr int I_WIN = 32 * (LDP / 64), I_W1 = 64 * 2, I_W2 = 2 * 2;
    constexpr int NIT = I_WIN + 2 * I_W1 + 2 * I_W2 + 32;
    for (int it = blockIdx.x; it < NIT; it += gridDim.x) {
        int r = it;
        if (r < I_WIN) { const int kb = r & 31, nb = r >> 5; transpose_tile(P.w_in, INDIM, P_winT, DM, kb * 64, nb * 64, 1, nullptr, tile); continue; } r -= I_WIN;
        if (r < I_W1) { transpose_tile(P.cmp_w1_k, 128, P_w1kT, 4096, (r >> 1) * 64, (r & 1) * 64, 0, nullptr, tile); continue; } r -= I_W1;
        if (r < I_W1) { transpose_tile(P.cmp_w1_v, 128, P_w1vT, 4096, (r >> 1) * 64, (r & 1) * 64, 0, nullptr, tile); continue; } r -= I_W1;
        if (r < I_W2) { transpose_tile(P.cmp_w2_k, 128, P_w2kT, 128, (r >> 1) * 64, (r & 1) * 64, 0, nullptr, tile); continue; } r -= I_W2;
        if (r < I_W2) { transpose_tile(P.cmp_w2_v, 128, P_w2vT, 128, (r >> 1) * 64, (r & 1) * 64, 0, nullptr, tile); continue; } r -= I_W2;
        {
            const int which = r >> 4, n0 = (r & 15) * 8;
            const float* pe = which ? P.cmp_pe_v : P.cmp_pe_k; const float* w1 = which ? P.cmp_w1_v : P.cmp_w1_k; const float* b1 = which ? P.cmp_b1_v : P.cmp_b1_k; float* bo = which ? P_biasv : P_biask;
            float acc8[8];
#pragma unroll
            for (int j = 0; j < 8; ++j) acc8[j] = 0.f;
#pragma unroll
            for (int i = 0; i < 8; ++i) { const int kk = tid + 512 * i; const float pv = pe[kk]; const f32x4 wa = *(const f32x4*)(w1 + (size_t)kk * 128 + n0), wb = *(const f32x4*)(w1 + (size_t)kk * 128 + n0 + 4);
                acc8[0] += pv * wa[0]; acc8[1] += pv * wa[1]; acc8[2] += pv * wa[2]; acc8[3] += pv * wa[3]; acc8[4] += pv * wb[0]; acc8[5] += pv * wb[1]; acc8[6] += pv * wb[2]; acc8[7] += pv * wb[3]; }
#pragma unroll
            for (int j = 0; j < 8; ++j) acc8[j] = wave_sum(acc8[j]);
            if (lane == 0) {
#pragma unroll
                for (int j = 0; j < 8; ++j) tile[wave * 8 + j] = acc8[j]; }
            __syncthreads();
            if (tid < 8) { float t = 0.f;
#pragma unroll
                for (int w = 0; w < 8; ++w) t += tile[w * 8 + tid];
                bo[n0 + tid] = b1[n0 + tid] + t; }
            __syncthreads();
        }
    }
}

constexpr int RS = 272;
constexpr int SSD_BS = 0, SSD_BWT = 34816, SSD_CS = 69632, SSD_XT = 104448, SSD_ST = 121856, SSD_CUM = 139264, SSD_WSC = 139776, SSD_DTV = 140288;

DI void phase_bcconv(const Params& P) {
    const int tid = opaque_tid();
    for (int it = blockIdx.x; it < 256; it += gridDim.x) {
        const int b = it >> 4, slab = it & 15; const int cg = tid & 7, seg = tid >> 3;
        const int c = 2048 + slab * 64 + cg * 8;
        bf16_t* base = P_proj + (size_t)b * TT * LDP + C_X + c;
        float w[4][8], bias[8];
#pragma unroll
        for (int k = 0; k < 4; ++k) { const f32x4 a = *(const f32x4*)(P.conv_w + k * 3072 + c), bb = *(const f32x4*)(P.conv_w + k * 3072 + c + 4);
            w[k][0] = a[0]; w[k][1] = a[1]; w[k][2] = a[2]; w[k][3] = a[3]; w[k][4] = bb[0]; w[k][5] = bb[1]; w[k][6] = bb[2]; w[k][7] = bb[3]; }
        { const f32x4 a = *(const f32x4*)(P.conv_b + c), bb = *(const f32x4*)(P.conv_b + c + 4); bias[0] = a[0]; bias[1] = a[1]; bias[2] = a[2]; bias[3] = a[3]; bias[4] = bb[0]; bias[5] = bb[1]; bias[6] = bb[2]; bias[7] = bb[3]; }
        float h[3][8];
        const int ts = seg * 32;
#pragma unroll
        for (int r = 0; r < 3; ++r) { const int t = ts - 3 + r; u32x4 row = {0u, 0u, 0u, 0u}; if (t >= 0) row = *(const u32x4*)(base + (size_t)t * LDP);
            const unsigned uw[4] = {row.x, row.y, row.z, row.w};
#pragma unroll
            for (int j = 0; j < 4; ++j) { h[r][2 * j] = lo16(uw[j]); h[r][2 * j + 1] = hi16(uw[j]); } }
        __syncthreads();
#pragma unroll 1
        for (int i = 0; i < 32; i += 8) {
            u32x4 rows[8];
#pragma unroll
            for (int q = 0; q < 8; ++q) rows[q] = *(const u32x4*)(base + (size_t)(ts + i + q) * LDP);
#pragma unroll
            for (int q = 0; q < 8; ++q) {
                const unsigned uw[4] = {rows[q].x, rows[q].y, rows[q].z, rows[q].w}; float cur[8], o[8];
#pragma unroll
                for (int j = 0; j < 4; ++j) { cur[2 * j] = lo16(uw[j]); cur[2 * j + 1] = hi16(uw[j]); }
#pragma unroll
                for (int j = 0; j < 8; ++j) { o[j] = siluf_(bias[j] + w[0][j] * h[0][j] + w[1][j] * h[1][j] + w[2][j] * h[2][j] + w[3][j] * cur[j]); h[0][j] = h[1][j]; h[1][j] = h[2][j]; h[2][j] = cur[j]; }
                u32x4 ov; ov.x = pk2(o[0], o[1]); ov.y = pk2(o[2], o[3]); ov.z = pk2(o[4], o[5]); ov.w = pk2(o[6], o[7]);
                *(u32x4*)(base + (size_t)(ts + i + q) * LDP) = ov;
            }
        }
        __syncthreads();
    }
}

constexpr int SSD_WCV = 140800;

template <int NT, int ROFF, int NR, int WS = 320>
DI void conv_regs(const u32x4 (&rows)[NR], const float* wl  , float (&out)[NT][8]) {
    float w[5][8];
#pragma unroll
    for (int k = 0; k < 5; ++k) { const f32x4 a = *(const f32x4*)(wl + k * WS), b = *(const f32x4*)(wl + k * WS + 4);
        w[k][0] = a[0]; w[k][1] = a[1]; w[k][2] = a[2]; w[k][3] = a[3]; w[k][4] = b[0]; w[k][5] = b[1]; w[k][6] = b[2]; w[k][7] = b[3]; }
#pragma unroll
    for (int tk = 0; tk < NT; ++tk)
#pragma unroll
        for (int c = 0; c < 8; ++c) out[tk][c] = w[4][c];
#pragma unroll
    for (int r = 0; r < NT + 3; ++r) {
        const u32x4 row = rows[ROFF + r]; const unsigned uw[4] = {row.x, row.y, row.z, row.w};
        float u[8];
#pragma unroll
        for (int j = 0; j < 4; ++j) { u[2 * j] = lo16(uw[j]); u[2 * j + 1] = hi16(uw[j]); }
#pragma unroll
        for (int k = 0; k < 4; ++k) { const int tk = r - k;
            if (tk >= 0 && tk < NT) {
#pragma unroll
                for (int c = 0; c < 8; ++c) out[tk][c] += w[k][c] * u[c]; } }
    }
#pragma unroll
    for (int tk = 0; tk < NT; ++tk)
#pragma unroll
        for (int c = 0; c < 8; ++c) out[tk][c] = siluf_(out[tk][c]);
}

DI void ssd_item(const Params& P, unsigned char* smem, int b, int hd) {
    const int tid0 = opaque_tid();
    const int g = hd >> 3;
    const float Aneg = -__expf(P.a_log[hd]), dtb = P.dt_bias[hd], Dsk = P.d_skip[hd];
    const bf16_t* pbase = P_proj + (size_t)b * TT * LDP;
    float* cum = (float*)(smem + SSD_CUM); float* wsc = (float*)(smem + SSD_WSC); float* dtv = (float*)(smem + SSD_DTV); float* wcv = (float*)(smem + SSD_WCV);
#define SSD_ROLES(tid) \
    const int lane = tid & 63, wave = tid >> 6, l32o = lane & 31, hho = lane >> 5, l32 = l32o, hh = hho; \
    const int lt = wave & 3, ph = wave >> 2; \
    const int cgi = tid & 31, run = tid >> 5; \
    const int chbc = (cgi < 16 ? 2048 + g * 128 + cgi * 8 : 2560 + g * 128 + (cgi - 16) * 8); \
    const int cgx = tid & 7, runx = tid >> 3; const int chx = hd * 64 + cgx * 8;
    __syncthreads();
    for (int i = tid0; i < 5 * 320; i += 512) { const int k = i / 320, c = i % 320; const int ch = c < 128 ? 2048 + g * 128 + c : (c < 256 ? 2560 + g * 128 + (c - 128) : hd * 64 + (c - 256));
        wcv[i] = (k < 4) ? P.conv_w[k * 3072 + ch] : P.conv_b[ch]; }
    f32x16 state;
#pragma unroll
    for (int i = 0; i < 16; ++i) state[i] = 0.f;
    u32x4 rbc[8], rx[5]; u32x2 zr[4]; float dr0 = 0.f, dr1 = 0.f;
#define SSD_BAR() do { asm volatile("s_waitcnt lgkmcnt(0)" ::: "memory"); __builtin_amdgcn_s_barrier(); asm volatile("" ::: "memory"); } while (0)
#define SSD_ISSUE_Z(T0) do { _Pragma("unroll") for (int ig = 0; ig < 4; ++ig) zr[ig] = *(const u32x2*)(pbase + (size_t)((T0) + 32 * lt + l32o) * LDP + C_Z + hd * 64 + 32 * ph + 8 * ig + 4 * hho); } while (0)
#define SSD_ISSUE(T0) do { \
        _Pragma("unroll") for (int r = 0; r < 8; ++r) { const int t = (T0) + run * 8 + r; rbc[r] = *(const u32x4*)(pbase + (size_t)t * LDP + C_X + chbc); } \
        _Pragma("unroll") for (int r = 0; r < 5; ++r) { const int t = (T0) + runx * 2 - 3 + r; rx[r] = (u32x4){0u, 0u, 0u, 0u}; if (t >= 0) rx[r] = *(const u32x4*)(pbase + (size_t)t * LDP + C_X + chx); } \
        if (wave == 0) { dr0 = bf2f(pbase[(size_t)((T0) + lane) * LDP + C_DT + hd]); dr1 = bf2f(pbase[(size_t)((T0) + 64 + lane) * LDP + C_DT + hd]); } } while (0)
    { SSD_ROLES(tid0) SSD_ISSUE(0); SSD_ISSUE_Z(0); }

    for (int c = 0; c < 16; ++c) {
        const int t0 = c * 128; const int tidc = opaque_i(tid0);
        SSD_ROLES(tidc)
        SSD_BAR();
        if (wave == 0) {
            const float r0 = dr0 + dtb, r1 = dr1 + dtb;
            const float d0 = r0 > 20.f ? r0 : log1pf(__expf(r0)), d1 = r1 > 20.f ? r1 : log1pf(__expf(r1));
            float c0 = d0 * Aneg, c1 = d1 * Aneg;
#pragma unroll
            for (int o = 1; o < 64; o <<= 1) { const float a0 = __shfl_up(c0, o), a1 = __shfl_up(c1, o); if (lane >= o) { c0 += a0; c1 += a1; } }
            const float tot0 = __shfl(c0, 63); c1 += tot0;
            const float last = __shfl(c1, 63);
            cum[lane] = c0; cum[64 + lane] = c1; dtv[lane] = d0; dtv[64 + lane] = d1;
            wsc[lane] = d0 * __expf(last - c0); wsc[64 + lane] = d1 * __expf(last - c1);
        }
        {
            const int o1 = opaque_i((32 * ph + 4 * hh) * RS + (32 * lt + l32) * 2);
#pragma unroll
            for (int i = 0; i < 16; ++i) *(bf16_t*)(smem + SSD_ST + o1 + ((i & 3) + 8 * (i >> 2)) * RS) = f2bf(state[i]);
        }
        SSD_BAR();
        {
            if (cgi < 16) {
                const int n0 = cgi * 8;
#pragma unroll
                for (int r = 0; r < 8; ++r) *(u32x4*)(smem + SSD_BS + (run * 8 + r) * RS + n0 * 2) = rbc[r];
                const f32x4 wsa = *(const f32x4*)(wsc + run * 8), wsb = *(const f32x4*)(wsc + run * 8 + 4);
                const float ws8[8] = {wsa[0], wsa[1], wsa[2], wsa[3], wsb[0], wsb[1], wsb[2], wsb[3]};
#pragma unroll
                for (int cc = 0; cc < 8; ++cc) { float v[8];
#pragma unroll
                    for (int r = 0; r < 8; ++r) { const unsigned wd = (cc >> 1) == 0 ? rbc[r].x : ((cc >> 1) == 1 ? rbc[r].y : ((cc >> 1) == 2 ? rbc[r].z : rbc[r].w)); v[r] = ((cc & 1) ? hi16(wd) : lo16(wd)) * ws8[r]; }
                    u32x4 w; w.x = pk2(v[0], v[1]); w.y = pk2(v[2], v[3]); w.z = pk2(v[4], v[5]); w.w = pk2(v[6], v[7]);
                    *(u32x4*)(smem + SSD_BWT + (n0 + cc) * RS + run * 16) = w; }
            } else {
                const int n0 = (cgi - 16) * 8;
#pragma unroll
                for (int r = 0; r < 8; ++r) *(u32x4*)(smem + SSD_CS + (run * 8 + r) * RS + n0 * 2) = rbc[r];
            }
            float ox[2][8];
            conv_regs<2, 0, 5>(rx, wcv + 256 + cgx * 8, ox);
#pragma unroll
            for (int cc = 0; cc < 8; ++cc) *(unsigned*)(smem + SSD_XT + (cgx * 8 + cc) * RS + runx * 4) = pk2(ox[0][cc], ox[1][cc]);
        }
        SSD_BAR();
        if (c < 15) SSD_ISSUE(t0 + 128);
        {
            const int l32 = opaque_i(l32o), hh = opaque_i(hho);
            const int l = 32 * lt + l32;
            const unsigned char* cfp = smem + SSD_CS + l * RS + 16 * hh;
#define CF(ks) (*(const bf16x8*)(cfp + 32 * (ks)))
            f32x16 acc;
#pragma unroll
            for (int i = 0; i < 16; ++i) acc[i] = 0.f;
#pragma unroll
            for (int ks = 0; ks < 8; ++ks) { const bf16x8 a = *(const bf16x8*)(smem + SSD_ST + (32 * ph + l32) * RS + (16 * ks + 8 * hh) * 2); acc = MFMA32(a, CF(ks), acc); }
            const float cl = cum[l];
            { const float e = __expf(cl);
#pragma unroll
              for (int i = 0; i < 16; ++i) acc[i] *= e; }
            for (int st = 0; st <= lt; ++st) {
                f32x16 S;
#pragma unroll
                for (int i = 0; i < 16; ++i) S[i] = 0.f;
#pragma unroll
                for (int ks = 0; ks < 8; ++ks) { const bf16x8 a = *(const bf16x8*)(smem + SSD_BS + (32 * st + l32) * RS + (16 * ks + 8 * hh) * 2); S = MFMA32(a, CF(ks), S); }
#pragma unroll
                for (int ig = 0; ig < 4; ++ig) { const int s0 = 32 * st + 8 * ig + 4 * hh; const f32x4 cs = *(const f32x4*)(cum + s0), dv = *(const f32x4*)(dtv + s0);
#pragma unroll
                    for (int j = 0; j < 4; ++j) { const float dec = __expf(fminf(cl - cs[j], 0.f)) * dv[j]; S[4 * ig + j] = (s0 + j <= l) ? S[4 * ig + j] * dec : 0.f; } }
#pragma unroll
                for (int s2 = 0; s2 < 2; ++s2) {
                    const bf16x8 mf = pack8(S, s2);
                    const unsigned char* xp = smem + SSD_XT + (32 * ph + l32) * RS + (32 * st + 16 * s2 + 4 * hh) * 2;
                    const bf16x8 a = cat44(*(const s16x4*)xp, *(const s16x4*)(xp + 16));
                    acc = MFMA32(a, mf, acc);
                }
            }
            const size_t tok = (size_t)b * TT + t0 + l; float ss = 0.f;
            const int xo = opaque_i((32 * ph + 4 * hh) * RS + l * 2);
#pragma unroll
            for (int ig = 0; ig < 4; ++ig) { const int p0 = 32 * ph + 8 * ig + 4 * hh;
                const u32x2 zz = zr[ig];
                const float zf[4] = {lo16(zz.x), hi16(zz.x), lo16(zz.y), hi16(zz.y)}; float y[4];
#pragma unroll
                for (int j = 0; j < 4; ++j) { const float xv = bf2f(*(const bf16_t*)(smem + SSD_XT + xo + (8 * ig + j) * RS)); y[j] = (acc[4 * ig + j] + Dsk * xv) * siluf_(zf[j]); ss += y[j] * y[j]; }
                u32x2 w; w.x = pk2(y[0], y[1]); w.y = pk2(y[2], y[3]);
                *(u32x2*)(P_yg + tok * 4096 + hd * 64 + p0) = w; }
            ss += __shfl_xor(ss, 32);
            if (hh == 0) P_part[tok * 64 + hd * 2 + ph] = ss;
            { const float e = __expf(cum[127]);
#pragma unroll
              for (int i = 0; i < 16; ++i) state[i] *= e; }
#pragma unroll
            for (int ks = 0; ks < 8; ++ks) {
                const bf16x8 a = *(const bf16x8*)(smem + SSD_XT + (32 * ph + l32) * RS + (16 * ks + 8 * hh) * 2);
                const bf16x8 bb = *(const bf16x8*)(smem + SSD_BWT + (32 * lt + l32) * RS + (16 * ks + 8 * hh) * 2);
                state = MFMA32(a, bb, state);
            }
            if (c < 15) SSD_ISSUE_Z(t0 + 128);
        }
    }
#undef SSD_ISSUE_Z
#undef SSD_ISSUE
#undef SSD_BAR
#undef CF
#undef SSD_ROLES
}

constexpr int RS2 = 144;
constexpr int S2_BS = 0, S2_CS = 17408, S2_HALF0 = 34816, S2_HSTRIDE = 47104;
constexpr int S2_BWT = 0, S2_XT = 18432, S2_ST = 27648, S2_CUM = 45056, S2_WSC = 45312, S2_DTV = 45568, S2_WCV = 45824;

DI void ssd_pair_item(const Params& P, unsigned char* smem, int b, int hp) {
    const int tid0 = opaque_tid();
    const int hd = 2 * hp + (tid0 >> 8), g = hp >> 2;
    const float Aneg = -__expf(P.a_log[hd]), dtb = P.dt_bias[hd], Dsk = P.d_skip[hd];
    const bf16_t* pbase = P_proj + (size_t)b * TT * LDP;
    unsigned char* hb = smem + S2_HALF0 + (tid0 >> 8) * S2_HSTRIDE;
    float* cum = (float*)(hb + S2_CUM); float* wsc = (float*)(hb + S2_WSC); float* dtv = (float*)(hb + S2_DTV); float* wcv = (float*)(hb + S2_WCV);
#define S2_ROLES(tid) \
    const int lane = tid & 63, wave = tid >> 6, wl = wave & 3, half = wave >> 2, l32o = lane & 31, hho = lane >> 5, l32 = l32o, hh = hho; \
    const int lt = wl & 1, ph = wl >> 1, tidh = tid & 255; \
    const int cg = tidh & 15, run = tidh >> 4; const int chb = 2048 + g * 128 + cg * 8, chc = 2560 + g * 128 + cg * 8; \
    const int cgx = tidh & 7, runx = tidh >> 3; const int chx = hd * 64 + cgx * 8;
    __syncthreads();
    for (int i = (tid0 & 255); i < 5 * 64; i += 256) { const int k = i >> 6, c = i & 63; const int ch = hd * 64 + c; wcv[i] = (k < 4) ? P.conv_w[k * 3072 + ch] : P.conv_b[ch]; }
    f32x16 state[2];
#pragma unroll
    for (int i = 0; i < 16; ++i) { state[0][i] = 0.f; state[1][i] = 0.f; }
    u32x4 rb[4], rc[4], rx[5]; u32x2 zr[4]; float dr0 = 0.f;
#pragma unroll
    for (int r = 0; r < 4; ++r) rc[r] = (u32x4){0u, 0u, 0u, 0u};
#define S2_BAR() do { asm volatile("s_waitcnt lgkmcnt(0)" ::: "memory"); __builtin_amdgcn_s_barrier(); asm volatile("" ::: "memory"); } while (0)
#define S2_ISSUE_Z(T0) do { _Pragma("unroll") for (int ig = 0; ig < 4; ++ig) zr[ig] = *(const u32x2*)(pbase + (size_t)((T0) + 32 * lt + l32o) * LDP + C_Z + hd * 64 + 32 * ph + 8 * ig + 4 * hho); } while (0)
#define S2_ISSUE(T0) do { \
        _Pragma("unroll") for (int r = 0; r < 4; ++r) { const int t = (T0) + run * 4 + r; rb[r] = *(const u32x4*)(pbase + (size_t)t * LDP + C_X + chb); if (half) rc[r] = *(const u32x4*)(pbase + (size_t)t * LDP + C_X + chc); } \
        _Pragma("unroll") for (int r = 0; r < 5; ++r) { const int t = (T0) + runx * 2 - 3 + r; rx[r] = (u32x4){0u, 0u, 0u, 0u}; if (t >= 0) rx[r] = *(const u32x4*)(pbase + (size_t)t * LDP + C_X + chx); } \
        if (wl == 0) dr0 = bf2f(pbase[(size_t)((T0) + lane) * LDP + C_DT + hd]); } while (0)
    { S2_ROLES(tid0) S2_ISSUE(0); S2_ISSUE_Z(0); }

    for (int c = 0; c < 32; ++c) {
        const int t0 = c * 64; const int tidc = opaque_i(tid0);
        S2_ROLES(tidc)
        S2_BAR();
        if (wl == 0) {
            const float r0 = dr0 + dtb;
            const float d0 = r0 > 20.f ? r0 : log1pf(__expf(r0));
            float c0 = d0 * Aneg;
#pragma unroll
            for (int o = 1; o < 64; o <<= 1) { const float a0 = __shfl_up(c0, o); if (lane >= o) c0 += a0; }
            const float last = __shfl(c0, 63);
            cum[lane] = c0; dtv[lane] = d0; wsc[lane] = d0 * __expf(last - c0);
        }
        {
#pragma unroll
            for (int q = 0; q < 2; ++q) {
                const int o1 = opaque_i((32 * ph + 4 * hh) * RS + (32 * (2 * lt + q) + l32) * 2);
#pragma unroll
                for (int i = 0; i < 16; ++i) *(bf16_t*)(hb + S2_ST + o1 + ((i & 3) + 8 * (i >> 2)) * RS) = f2bf(state[q][i]);
            }
        }
        S2_BAR();
        {
            if (half == 0) {
#pragma unroll
                for (int r = 0; r < 4; ++r) *(u32x4*)(smem + S2_BS + (run * 4 + r) * RS + cg * 16) = rb[r];
            } else {
#pragma unroll
                for (int r = 0; r < 4; ++r) *(u32x4*)(smem + S2_CS + (run * 4 + r) * RS + cg * 16) = rc[r];
            }
            const f32x4 ws4 = *(const f32x4*)(wsc + run * 4);
#pragma unroll
            for (int cc = 0; cc < 8; ++cc) { float v[4];
#pragma unroll
                for (int r = 0; r < 4; ++r) { const unsigned wd = (cc >> 1) == 0 ? rb[r].x : ((cc >> 1) == 1 ? rb[r].y : ((cc >> 1) == 2 ? rb[r].z : rb[r].w)); v[r] = ((cc & 1) ? hi16(wd) : lo16(wd)) * ws4[r]; }
                u32x2 w; w.x = pk2(v[0], v[1]); w.y = pk2(v[2], v[3]);
                *(u32x2*)(hb + S2_BWT + (cg * 8 + cc) * RS2 + run * 8) = w; }
            float ox[2][8];
            conv_regs<2, 0, 5, 64>(rx, wcv + cgx * 8, ox);
#pragma unroll
            for (int cc = 0; cc < 8; ++cc) *(unsigned*)(hb + S2_XT + (cgx * 8 + cc) * RS2 + runx * 4) = pk2(ox[0][cc], ox[1][cc]);
        }
        S2_BAR();
        if (c < 31) S2_ISSUE(t0 + 64);
        {
            const int l32 = opaque_i(l32o), hh = opaque_i(hho);
            const int l = 32 * lt + l32;
            const unsigned char* cfp = smem + S2_CS + l * RS + 16 * hh;
#define CF2(ks) (*(const bf16x8*)(cfp + 32 * (ks)))
            f32x16 acc;
#pragma unroll
            for (int i = 0; i < 16; ++i) acc[i] = 0.f;
#pragma unroll
            for (int ks = 0; ks < 8; ++ks) { const bf16x8 a = *(const bf16x8*)(hb + S2_ST + (32 * ph + l32) * RS + (16 * ks + 8 * hh) * 2); acc = MFMA32(a, CF2(ks), acc); }
            const float cl = cum[l];
            { const float e = __expf(cl);
#pragma unroll
              for (int i = 0; i < 16; ++i) acc[i] *= e; }
            for (int st = 0; st <= lt; ++st) {
                f32x16 S;
#pragma unroll
                for (int i = 0; i < 16; ++i) S[i] = 0.f;
#pragma unroll
                for (int ks = 0; ks < 8; ++ks) { const bf16x8 a = *(const bf16x8*)(smem + S2_BS + (32 * st + l32) * RS + (16 * ks + 8 * hh) * 2); S = MFMA32(a, CF2(ks), S); }
#pragma unroll
                for (int ig = 0; ig < 4; ++ig) { const int s0 = 32 * st + 8 * ig + 4 * hh; const f32x4 cs = *(const f32x4*)(cum + s0), dv = *(const f32x4*)(dtv + s0);
#pragma unroll
                    for (int j = 0; j < 4; ++j) { const float dec = __expf(fminf(cl - cs[j], 0.f)) * dv[j]; S[4 * ig + j] = (s0 + j <= l) ? S[4 * ig + j] * dec : 0.f; } }
#pragma unroll
                for (int s2 = 0; s2 < 2; ++s2) {
                    const bf16x8 mf = pack8(S, s2);
                    const unsigned char* xp = hb + S2_XT + (32 * ph + l32) * RS2 + (32 * st + 16 * s2 + 4 * hh) * 2;
                    const bf16x8 a = cat44(*(const s16x4*)xp, *(const s16x4*)(xp + 16));
                    acc = MFMA32(a, mf, acc);
                }
            }
            const size_t tok = (size_t)b * TT + t0 + l; float ss = 0.f;
            const int xo = opaque_i((32 * ph + 4 * hh) * RS2 + l * 2);
#pragma unroll
            for (int ig = 0; ig < 4; ++ig) { const int p0 = 32 * ph + 8 * ig + 4 * hh;
                const u32x2 zz = zr[ig];
                const float zf[4] = {lo16(zz.x), hi16(zz.x), lo16(zz.y), hi16(zz.y)}; float y[4];
#pragma unroll
                for (int j = 0; j < 4; ++j) { const float xv = bf2f(*(const bf16_t*)(hb + S2_XT + xo + (8 * ig + j) * RS2)); y[j] = (acc[4 * ig + j] + Dsk * xv) * siluf_(zf[j]); ss += y[j] * y[j]; }
                u32x2 w; w.x = pk2(y[0], y[1]); w.y = pk2(y[2], y[3]);
                *(u32x2*)(P_yg + tok * 4096 + hd * 64 + p0) = w; }
            ss += __shfl_xor(ss, 32);
            if (hh == 0) P_part[tok * 64 + hd * 2 + ph] = ss;
            { const float e = __expf(cum[63]);
#pragma unroll
              for (int i = 0; i < 16; ++i) { state[0][i] *= e; state[1][i] *= e; } }
#pragma unroll
            for (int ks = 0; ks < 4; ++ks) {
                const bf16x8 a = *(const bf16x8*)(hb + S2_XT + (32 * ph + l32) * RS2 + (16 * ks + 8 * hh) * 2);
#pragma unroll
                for (int q = 0; q < 2; ++q) { const bf16x8 bb = *(const bf16x8*)(hb + S2_BWT + (32 * (2 * lt + q) + l32) * RS2 + (16 * ks + 8 * hh) * 2); state[q] = MFMA32(a, bb, state[q]); }
            }
            if (c < 31) S2_ISSUE_Z(t0 + 64);
        }
    }
#undef S2_ISSUE_Z
#undef S2_ISSUE
#undef S2_BAR
#undef CF2
#undef S2_ROLES
}

DI void knorm16(const u32x4 a, const u32x4 c2, const float* nw, u32x4& o0, u32x4& o1) {
    const unsigned uw[8] = {a.x, a.y, a.z, a.w, c2.x, c2.y, c2.z, c2.w}; float v[16]; float s = 0.f;
#pragma unroll
    for (int j = 0; j < 8; ++j) { v[2 * j] = lo16(uw[j]); v[2 * j + 1] = hi16(uw[j]); s += v[2 * j] * v[2 * j] + v[2 * j + 1] * v[2 * j + 1]; }
    s += __shfl_xor(s, 1); s += __shfl_xor(s, 2); s += __shfl_xor(s, 4);
    const float rstd = 1.f / sqrtf(s * (1.f / 128.f) + EPSF);
    o0.x = pk2(v[0] * rstd * nw[0], v[1] * rstd * nw[1]); o0.y = pk2(v[2] * rstd * nw[2], v[3] * rstd * nw[3]); o0.z = pk2(v[4] * rstd * nw[4], v[5] * rstd * nw[5]); o0.w = pk2(v[6] * rstd * nw[6], v[7] * rstd * nw[7]);
    o1.x = pk2(v[8] * rstd * nw[8], v[9] * rstd * nw[9]); o1.y = pk2(v[10] * rstd * nw[10], v[11] * rstd * nw[11]); o1.z = pk2(v[12] * rstd * nw[12], v[13] * rstd * nw[13]); o1.w = pk2(v[14] * rstd * nw[14], v[15] * rstd * nw[15]);
}
DI void kvprep_item(const Params& P, unsigned char* smem, int item) {
    const int tid = opaque_tid(); const int tt = item & 31, g = (item >> 5) & 1, b = item >> 6; const int t0 = tt * 64;
    bf16_t* pb = P_proj + ((size_t)b * TT + t0) * LDP;
    const int tk = tid >> 3, part = tid & 7;
    bf16_t* kp0 = pb + (size_t)tk * LDP + C_KSLC + g * 128 + part * 16; bf16_t* kp1 = pb + (size_t)tk * LDP + C_KWIN + g * 128 + part * 16;
    const bf16_t* vp0 = pb + (size_t)tk * LDP + C_VSLC + g * 128 + part * 16; const bf16_t* vp1 = pb + (size_t)tk * LDP + C_VWIN + g * 128 + part * 16;
    const u32x4 k0a = *(const u32x4*)kp0, k0b = *(const u32x4*)(kp0 + 8), k1a = *(const u32x4*)kp1, k1b = *(const u32x4*)(kp1 + 8);
    const u32x4 v0a = *(const u32x4*)vp0, v0b = *(const u32x4*)(vp0 + 8), v1a = *(const u32x4*)vp1, v1b = *(const u32x4*)(vp1 + 8);
    { u32x4 o0, o1; knorm16(k0a, k0b, P.k_slc_norm_w + part * 16, o0, o1); *(u32x4*)kp0 = o0; *(u32x4*)(kp0 + 8) = o1;
      knorm16(k1a, k1b, P.k_win_norm_w + part * 16, o0, o1); *(u32x4*)kp1 = o0; *(u32x4*)(kp1 + 8) = o1; }
    bf16_t* tile0 = (bf16_t*)smem; bf16_t* tile1 = tile0 + 64 * 130;
    LDS_BAR();
    { unsigned* tp = (unsigned*)(tile0 + tk * 130 + part * 16); const unsigned uw[8] = {v0a.x, v0a.y, v0a.z, v0a.w, v0b.x, v0b.y, v0b.z, v0b.w};
#pragma unroll
      for (int j = 0; j < 8; ++j) tp[j] = uw[j];
      unsigned* tq = (unsigned*)(tile1 + tk * 130 + part * 16); const unsigned ux[8] = {v1a.x, v1a.y, v1a.z, v1a.w, v1b.x, v1b.y, v1b.z, v1b.w};
#pragma unroll
      for (int j = 0; j < 8; ++j) tq[j] = ux[j]; }
    LDS_BAR();
    { const int d = tid >> 2, prt = tid & 3;
#pragma unroll
      for (int which = 0; which < 2; ++which) { const bf16_t* tile = which ? tile1 : tile0; unsigned w[8];
#pragma unroll
          for (int j = 0; j < 8; ++j) w[j] = (unsigned)tile[(prt * 16 + 2 * j) * 130 + d] | ((unsigned)tile[(prt * 16 + 2 * j + 1) * 130 + d] << 16);
          bf16_t* op = (which ? P_vwinT : P_vslcT) + ((size_t)(b * 2 + g) * 128 + d) * TT + t0 + prt * 16;
          *(u32x4*)op = (u32x4){w[0], w[1], w[2], w[3]}; *(u32x4*)(op + 8) = (u32x4){w[4], w[5], w[6], w[7]}; } }
    LDS_BAR();
}

DI void compress_item(const Params& P, unsigned char* smem, int item) {
    const int tid = opaque_tid(), lane = tid & 63, wave = tid >> 6, l32 = lane & 31, hh = lane >> 5;
    const int ct = item & 3, g = (item >> 2) & 1, b = (item >> 3) & 15, which = item >> 7;
    const int nt = wave & 3, kh = wave >> 2;
    const bf16_t* src = P_proj + (size_t)b * TT * LDP + (which ? C_VCMP : C_KCMP) + g * 128;
    const bf16_t* w1T = which ? P_w1vT : P_w1kT; const bf16_t* w2T = which ? P_w2vT : P_w2kT; const float* bias = which ? P_biasv : P_biask;
    float* red = (float*)smem;
    bf16_t* hid = (bf16_t*)(smem + 16384);
    float* outf = (float*)(smem + 32768);
    int crow_a = ct * 32 + l32; if (crow_a > 126) crow_a = 126;
    f32x16 acc;
#pragma unroll
    for (int i = 0; i < 16; ++i) acc[i] = 0.f;
#pragma unroll 4
    for (int l = 16 * kh; l < 16 * kh + 16; ++l) {
        const bf16_t* arow = src + (size_t)(16 * crow_a + l) * LDP; const bf16_t* brow = w1T + (size_t)(32 * nt + l32) * 4096 + l * 128;
#pragma unroll
        for (int ks = 0; ks < 8; ++ks) { const bf16x8 a = *(const bf16x8*)(arow + 16 * ks + 8 * hh), bb = *(const bf16x8*)(brow + 16 * ks + 8 * hh); acc = MFMA32(a, bb, acc); }
    }
    __syncthreads();
    if (kh == 1) {
#pragma unroll
        for (int i = 0; i < 16; ++i) red[(nt * 64 + lane) * 16 + i] = acc[i]; }
    __syncthreads();
    if (kh == 0) {
        const float bn = bias[32 * nt + l32];
#pragma unroll
        for (int i = 0; i < 16; ++i) { const float v = acc[i] + red[(nt * 64 + lane) * 16 + i] + bn; hid[crow(i, hh) * 136 + 32 * nt + l32] = f2bf(siluf_(v)); } }
    __syncthreads();
    if (kh == 0) {
        f32x16 o;
#pragma unroll
        for (int i = 0; i < 16; ++i) o[i] = 0.f;
#pragma unroll
        for (int ks = 0; ks < 8; ++ks) { const bf16x8 a = *(const bf16x8*)(hid + l32 * 136 + 16 * ks + 8 * hh), bb = *(const bf16x8*)(w2T + (size_t)(32 * nt + l32) * 128 + 16 * ks + 8 * hh); o = MFMA32(a, bb, o); }
#pragma unroll
        for (int i = 0; i < 16; ++i) outf[crow(i, hh) * 132 + 32 * nt + l32] = o[i];
    }
    __syncthreads();
    if (which == 0) {
        const int r = tid >> 4, part = tid & 15; float v[8]; float s = 0.f;
#pragma unroll
        for (int j = 0; j < 8; ++j) { v[j] = outf[r * 132 + part * 8 + j]; s += v[j] * v[j]; }
        s += __shfl_xor(s, 1); s += __shfl_xor(s, 2); s += __shfl_xor(s, 4); s += __shfl_xor(s, 8);
        const float rstd = 1.f / sqrtf(s * (1.f / 128.f) + EPSF); const float* nw = P.k_cmp_norm_w + part * 8;
        const int cidx = ct * 32 + r; u32x4 w = {0u, 0u, 0u, 0u};
        if (cidx < 127) { w.x = pk2(v[0] * rstd * nw[0], v[1] * rstd * nw[1]); w.y = pk2(v[2] * rstd * nw[2], v[3] * rstd * nw[3]); w.z = pk2(v[4] * rstd * nw[4], v[5] * rstd * nw[5]); w.w = pk2(v[6] * rstd * nw[6], v[7] * rstd * nw[7]); }
        *(u32x4*)(P_kc + ((size_t)(b * 2 + g) * 128 + cidx) * 128 + part * 8) = w;
    } else {
        const int d = tid >> 2, part = tid & 3; unsigned w[4];
#pragma unroll
        for (int j = 0; j < 4; ++j) { const int r0 = part * 8 + 2 * j; const float v0 = (ct * 32 + r0 < 127) ? outf[r0 * 132 + d] : 0.f, v1 = (ct * 32 + r0 + 1 < 127) ? outf[(r0 + 1) * 132 + d] : 0.f; w[j] = pk2(v0, v1); }
        *(u32x4*)(P_vcT + ((size_t)(b * 2 + g) * 128 + d) * 128 + ct * 32 + part * 8) = (u32x4){w[0], w[1], w[2], w[3]};
    }
    __syncthreads();
}

DI void phase_mix(const Params& P, unsigned char* smem) {
    constexpr int I_SSD = 256, I_KV = 1024, I_CMP = 256, I_WT = 3 * 1024;
    constexpr int NIT = I_SSD + I_KV + I_CMP + I_WT;
    for (int it = blockIdx.x; it < NIT; it += gridDim.x) {
        int r = it;
        if (r < I_SSD) { ssd_pair_item(P, smem, r >> 4, r & 15); __syncthreads(); continue; } r -= I_SSD;
        if (r < I_KV) { kvprep_item(P, smem, r); continue; } r -= I_KV;
        if (r < I_CMP) { compress_item(P, smem, r); continue; } r -= I_CMP;
        { const int m = r >> 10, t = r & 1023, kb = t & 31, nb = t >> 5; float* tile = (float*)smem;
          if (m == 0) transpose_tile(P.w_out_ssd, DM, P_wossdT, 4096, kb * 64, nb * 64, 0, P.ssd_norm_w, tile);
          else if (m == 1) transpose_tile(P.w_out_nsa, DM, P_wossdT + 2048, 4096, kb * 64, nb * 64, 0, nullptr, tile);
          else transpose_tile(P.w_o, DM, P_woT, DM, kb * 64, nb * 64, 0, nullptr, tile); }
    }
}

constexpr int NSA_WAVE_LDS = 16384, NSA_K_OFF = 0, NSA_V_OFF = 8192;
constexpr float SM_SCALE = 0.08838834764831845f * 1.4426950408889634f;

struct AttnState { f32x16 acc[4]; float m, l; };

DI void dma_k_tile(LAS unsigned char* wl, const bf16_t* krow0, unsigned kstride_b, int lane) {
    const int rr = lane >> 4, c0 = (lane & 15) ^ rr;
    const unsigned lo = (unsigned)rr * kstride_b;
#pragma unroll
    for (int j = 0; j < 8; ++j) { const unsigned voff = lo + (unsigned)((c0 ^ ((4 * j) & 15)) * 16); const char* ub = (const char*)krow0 + (size_t)(4 * j) * kstride_b;
        __builtin_amdgcn_global_load_lds((const unsigned*)(ub + voff), (LAS unsigned*)(wl + NSA_K_OFF + j * 1024), 16, 0, 0); }
}
DI void dma_v_tile(LAS unsigned char* wl, const bf16_t* vcol0, unsigned vtstride_b, int lane) {
    const int dr = lane >> 2, vpos = lane & 3;
    const unsigned voff = (unsigned)dr * vtstride_b + (unsigned)((vpos ^ ((dr >> 2) & 3)) * 16);
#pragma unroll
    for (int j = 0; j < 8; ++j) { const char* ub = (const char*)vcol0 + (size_t)(16 * j) * vtstride_b;
        __builtin_amdgcn_global_load_lds((const unsigned*)(ub + voff), (LAS unsigned*)(wl + NSA_V_OFF + j * 1024), 16, 0, 0); }
}
DI f32x16 qk_tile(LAS unsigned char* wl, const bf16x8 (&qf)[8], int lane) {
    const int l32 = lane & 31, hh = lane >> 5;
    f32x16 S;
#pragma unroll
    for (int i = 0; i < 16; ++i) S[i] = 0.f;
#pragma unroll
    for (int ks = 0; ks < 8; ++ks) { const bf16x8 a = *(const LAS bf16x8*)(wl + NSA_K_OFF + l32 * 256 + (((2 * ks + hh) ^ (l32 & 15)) * 16)); S = MFMA32(a, qf[ks], S); }
    return S;
}

template <int MODE>
DI void attn_tile(LAS unsigned char* wl, const bf16_t* kbase, unsigned kstride, const bf16_t* vtbase, unsigned vtstride, int key_base, const bf16x8 (&qf)[8],
                  AttnState& st, int tq, bool rowsel, int lane_in) {
    const int lane = opaque_i(lane_in);
    const int l32 = lane & 31, hh = lane >> 5;
    LDS_FENCE();
    dma_k_tile(wl, kbase + (size_t)key_base * kstride, kstride * 2u, lane);
    dma_v_tile(wl, vtbase + key_base, vtstride * 2u, lane);
    asm volatile("s_waitcnt vmcnt(8)" ::: "memory");
    f32x16 S = qk_tile(wl, qf, lane);
    float mx = -1e30f;
#pragma unroll
    for (int i = 0; i < 16; ++i) { const int pos = key_base + crow(i, hh); bool ok;
        if (MODE == 0) ok = (16 * pos + 31 <= tq); else if (MODE == 1) ok = rowsel && (pos <= tq); else ok = (pos <= tq) && (pos > tq - 512);
        const float xv = ok ? S[i] * SM_SCALE : -1e30f; S[i] = xv; mx = fmaxf(mx, xv); }
    mx = fmaxf(mx, __shfl_xor(mx, 32));
    const float mnew = fmaxf(st.m, mx), alpha = __builtin_amdgcn_exp2f(st.m - mnew); float ps = 0.f;
#pragma unroll
    for (int i = 0; i < 16; ++i) { const float p = (S[i] > -1e29f) ? __builtin_amdgcn_exp2f(S[i] - mnew) : 0.f; S[i] = p; ps += p; }
    ps += __shfl_xor(ps, 32);
    st.l = st.l * alpha + ps; st.m = mnew;
#pragma unroll
    for (int dt = 0; dt < 4; ++dt)
#pragma unroll
        for (int i = 0; i < 16; ++i) st.acc[dt][i] *= alpha;
    const bf16x8 p0 = pack8(S, 0), p1 = pack8(S, 1);
    asm volatile("s_waitcnt vmcnt(0)" ::: "memory");
#pragma unroll
    for (int dt = 0; dt < 4; ++dt) {
        const int d = 32 * dt + l32, sw = (d >> 2) & 3;
        LAS unsigned char* vp = wl + NSA_V_OFF + d * 64 + 8 * hh;
        const bf16x8 a0 = cat44(*(const LAS s16x4*)(vp + ((0 ^ sw) * 16)), *(const LAS s16x4*)(vp + ((1 ^ sw) * 16))), a1 = cat44(*(const LAS s16x4*)(vp + ((2 ^ sw) * 16)), *(const LAS s16x4*)(vp + ((3 ^ sw) * 16)));
        st.acc[dt] = MFMA32(a0, p0, st.acc[dt]); st.acc[dt] = MFMA32(a1, p1, st.acc[dt]);
    }
}

DI void attn_reset(AttnState& st) {
    st.m = -1e30f; st.l = 0.f;
#pragma unroll
    for (int dt = 0; dt < 4; ++dt)
#pragma unroll
        for (int i = 0; i < 16; ++i) st.acc[dt][i] = 0.f;
}

DI void nsa_item(const Params& P, LAS unsigned char* wl, int b, int g, int t0, int lane_in) {
    const int lane = opaque_i(lane_in);
    const int l32 = lane & 31, hh = lane >> 5; const int tki = l32 >> 3, head = g * 8 + (l32 & 7); const int tq = t0 + tki;
    const unsigned tok = (unsigned)(b * TT + tq); const unsigned poff = tok * (unsigned)LDP; const unsigned ooff = tok * 4096u + 2048u + (unsigned)head * 128u;
    bf16x8 qf[8];
    {
        float qv[64]; float s = 0.f;
#pragma unroll
        for (int ks = 0; ks < 8; ++ks) { const u32x4 a = *(const u32x4*)(P_proj + (poff + C_Q + head * 128 + 16 * ks + 8 * hh)); const unsigned uw[4] = {a.x, a.y, a.z, a.w};
#pragma unroll
            for (int j = 0; j < 4; ++j) { const float v0 = lo16(uw[j]), v1 = hi16(uw[j]); qv[8 * ks + 2 * j] = v0; qv[8 * ks + 2 * j + 1] = v1; s += v0 * v0 + v1 * v1; } }
        s += __shfl_xor(s, 32);
        const float rstd = 1.f / sqrtf(s * (1.f / 128.f) + EPSF);
#pragma unroll
        for (int ks = 0; ks < 8; ++ks) { const f32x4 w0 = *(const f32x4*)(P.q_norm_w + 16 * ks + 8 * hh), w1 = *(const f32x4*)(P.q_norm_w + 16 * ks + 8 * hh + 4);
            u32x4 o; o.x = pk2(qv[8 * ks + 0] * rstd * w0[0], qv[8 * ks + 1] * rstd * w0[1]); o.y = pk2(qv[8 * ks + 2] * rstd * w0[2], qv[8 * ks + 3] * rstd * w0[3]);
            o.z = pk2(qv[8 * ks + 4] * rstd * w1[0], qv[8 * ks + 5] * rstd * w1[1]); o.w = pk2(qv[8 * ks + 6] * rstd * w1[2], qv[8 * ks + 7] * rstd * w1[3]);
            qf[ks] = __builtin_bit_cast(bf16x8, o); }
    }
    AttnState st;
    const bf16_t* kcb = P_kc + (size_t)(b * 2 + g) * 128 * 128; const bf16_t* vcb = P_vcT + (size_t)(b * 2 + g) * 128 * 128;
    const int ncv = (t0 + 3 >= 31) ? ((t0 + 3 - 31) >> 4) + 1 : 0;
    const int nct = (ncv + 31) >> 5;
    attn_reset(st);
    for (int kt = 0; kt < nct; ++kt) attn_tile<0>(wl, kcb, 128, vcb, 128, kt * 32, qf, st, tq, true, lane);
    {
        const float g0 = sigmoidf_(bf2f(P_proj[poff + C_GATE + head * 3 + 0]));
        const float inv = st.l > 0.f ? g0 / st.l : 0.f;
#pragma unroll
        for (int dt = 0; dt < 4; ++dt)
#pragma unroll
            for (int ig = 0; ig < 4; ++ig) { const int d0 = 32 * dt + 8 * ig + 4 * hh;
                u32x2 w; w.x = pk2(st.acc[dt][4 * ig] * inv, st.acc[dt][4 * ig + 1] * inv); w.y = pk2(st.acc[dt][4 * ig + 2] * inv, st.acc[dt][4 * ig + 3] * inv);
                *(u32x2*)(P_onsa + (ooff + d0)) = w; }
    }
    LAS float* psum = (LAS float*)(wl + NSA_V_OFF); LAS float* vals = (LAS float*)(wl + NSA_V_OFF + 2048);
    {
        const float invl = st.l > 0.f ? 1.f / st.l : 0.f; const float mfin = st.m;
        asm volatile("" ::: "memory");
        for (int i = lane; i < 512; i += 64) psum[i] = 0.f;
        LDS_FENCE();
        for (int kt = 0; kt < nct; ++kt) {
            LDS_FENCE();
            dma_k_tile(wl, kcb + (size_t)kt * 32 * 128, 256u, lane);
            asm volatile("s_waitcnt vmcnt(0)" ::: "memory");
            f32x16 S = qk_tile(wl, qf, lane);
#pragma unroll
            for (int i = 0; i < 16; ++i) { const int cidx = kt * 32 + crow(i, hh); const bool ok = (16 * cidx + 31 <= tq);
                float p = ok ? __builtin_amdgcn_exp2f(S[i] * SM_SCALE - mfin) * invl : 0.f;
                p += __shfl_xor(p, 1); p += __shfl_xor(p, 2); p += __shfl_xor(p, 4);
                if ((lane & 7) == 0) psum[tki * 128 + cidx] = p; }
            LDS_FENCE();
        }
    }
    unsigned selm[4];
#pragma unroll
    for (int tt = 0; tt < 2; ++tt) {
        const int tkn = 2 * tt + hh, j = l32; const int tqq = t0 + tkn, cur = tqq >> 6;
        float imp = 0.f;
#pragma unroll
        for (int c = -1; c < 4; ++c) { const int ci = 4 * j + c; if (ci >= 0) imp += psum[tkn * 128 + ci]; }
        const bool forced = (j == cur) || (j == 0), validb = (j <= cur);
        const unsigned key = forced ? 0x7f000000u : (validb ? (__float_as_uint(fmaxf(imp, 0.f)) + 1u) : 0u);
        ((LAS unsigned*)vals)[tkn * 32 + j] = key;
        LDS_FENCE();
        const unsigned long long kk = ((unsigned long long)key << 5) | (unsigned)(31 - j);
        int rank = 0;
#pragma unroll 4
        for (int jj = 0; jj < 32; ++jj) { const unsigned long long ko = ((unsigned long long)((LAS unsigned*)vals)[tkn * 32 + jj] << 5) | (unsigned)(31 - jj); rank += (ko > kk) ? 1 : 0; }
        const unsigned long long bal = __ballot(rank < 8);
        selm[2 * tt] = (unsigned)bal; selm[2 * tt + 1] = (unsigned)(bal >> 32);
    }
    LDS_FENCE();
    const unsigned mysel = tki == 0 ? selm[0] : (tki == 1 ? selm[1] : (tki == 2 ? selm[2] : selm[3]));
    {
        const int curb = t0 >> 6; const unsigned validm = (curb >= 31) ? 0xffffffffu : ((2u << curb) - 1u);
        unsigned U = (selm[0] | selm[1] | selm[2] | selm[3]) & validm;
        const bf16_t* kb = P_proj + (size_t)b * TT * LDP + C_KSLC + g * 128; const bf16_t* vb = P_vslcT + (size_t)(b * 2 + g) * 128 * TT;
        attn_reset(st);
        while (U) {
            const int j = __builtin_ctz(U); U &= U - 1u; const bool rs = (mysel >> j) & 1u;
            attn_tile<1>(wl, kb, LDP, vb, TT, 64 * j, qf, st, tq, rs, lane);
            if (64 * j + 32 <= t0 + 3) attn_tile<1>(wl, kb, LDP, vb, TT, 64 * j + 32, qf, st, tq, rs, lane);
        }
        const float g1 = sigmoidf_(bf2f(P_proj[poff + C_GATE + head * 3 + 1]));
        const float inv = st.l > 0.f ? g1 / st.l : 0.f;
#pragma unroll
        for (int dt = 0; dt < 4; ++dt)
#pragma unroll
            for (int ig = 0; ig < 4; ++ig) { const int d0 = 32 * dt + 8 * ig + 4 * hh; u32x2* op = (u32x2*)(P_onsa + (ooff + d0)); const u32x2 pv = *op;
                u32x2 w; w.x = pk2(lo16(pv.x) + st.acc[dt][4 * ig] * inv, hi16(pv.x) + st.acc[dt][4 * ig + 1] * inv); w.y = pk2(lo16(pv.y) + st.acc[dt][4 * ig + 2] * inv, hi16(pv.y) + st.acc[dt][4 * ig + 3] * inv);
                *op = w; }
    }
    {
        const bf16_t* kb = P_proj + (size_t)b * TT * LDP + C_KWIN + g * 128; const bf16_t* vb = P_vwinT + (size_t)(b * 2 + g) * 128 * TT;
        int lo = t0 - 511; if (lo < 0) lo = 0; lo &= ~31;
        attn_reset(st);
        for (int kb0 = lo; kb0 <= t0 + 3; kb0 += 32) attn_tile<2>(wl, kb, LDP, vb, TT, kb0, qf, st, tq, true, lane);
        const float g2 = sigmoidf_(bf2f(P_proj[poff + C_GATE + head * 3 + 2]));
        const float inv = st.l > 0.f ? g2 / st.l : 0.f;
#pragma unroll
        for (int dt = 0; dt < 4; ++dt)
#pragma unroll
            for (int i = 0; i < 16; ++i) st.acc[dt][i] *= inv;
    }
#pragma unroll
    for (int dt = 0; dt < 4; ++dt)
#pragma unroll
        for (int ig = 0; ig < 4; ++ig) { const int d0 = 32 * dt + 8 * ig + 4 * hh;
            const u32x2 zz = *(const u32x2*)(P_proj + (poff + C_ZNSA + head * 128 + d0));
            const u32x2 pv = *(const u32x2*)(P_onsa + (ooff + d0));
            const float o0 = st.acc[dt][4 * ig + 0] + lo16(pv.x), o1 = st.acc[dt][4 * ig + 1] + hi16(pv.x), o2 = st.acc[dt][4 * ig + 2] + lo16(pv.y), o3 = st.acc[dt][4 * ig + 3] + hi16(pv.y);
            u32x2 w; w.x = pk2(o0 * siluf_(lo16(zz.x)), o1 * siluf_(hi16(zz.x))); w.y = pk2(o2 * siluf_(lo16(zz.y)), o3 * siluf_(hi16(zz.y)));
            *(u32x2*)(P_onsa + (ooff + d0)) = w; }
}

constexpr int CO_RING = 0, CO_TOT = 65536, CO_SCR = 131072, CO_LIST = 151552, CO_UW = 152576;

DI void co_issue(const Params& P, LAS unsigned char* ring, int slot, unsigned desc, int b, int g, int wave, int lane) {
    const int mode = (int)(desc >> 16), key_base = (int)(desc & 0xffffu);
    const bf16_t* kb; const bf16_t* vb; unsigned ks_b, vs_b;
    if (mode <= 1) { kb = P_kc + (size_t)(b * 2 + g) * 128 * 128; ks_b = 256u; vb = P_vcT + (size_t)(b * 2 + g) * 128 * 128; vs_b = 256u; }
    else if (mode == 2) { kb = P_proj + (size_t)b * TT * LDP + C_KWIN + g * 128; ks_b = LDP * 2u; vb = P_vwinT + (size_t)(b * 2 + g) * 128 * TT; vs_b = TT * 2u; }
    else { kb = P_proj + (size_t)b * TT * LDP + C_KSLC + g * 128; ks_b = LDP * 2u; vb = P_vslcT + (size_t)(b * 2 + g) * 128 * TT; vs_b = TT * 2u; }
    LAS unsigned char* st = ring + slot * 16384;
    { const int rr = lane >> 4, c0 = (lane & 15) ^ rr; const unsigned voff = (unsigned)rr * ks_b + (unsigned)((c0 ^ ((4 * wave) & 15)) * 16);
      const char* ub = (const char*)kb + (size_t)(key_base + 4 * wave) * ks_b;
      __builtin_amdgcn_global_load_lds((const unsigned*)(ub + voff), (LAS unsigned*)(st + wave * 1024), 16, 0, 0); }
    { const int dr = lane >> 2, vpos = lane & 3; const unsigned voff = (unsigned)dr * vs_b + (unsigned)((vpos ^ ((dr >> 2) & 3)) * 16);
      const char* ub = (const char*)vb + (size_t)(16 * wave) * vs_b + (size_t)key_base * 2;
      __builtin_amdgcn_global_load_lds((const unsigned*)(ub + voff), (LAS unsigned*)(st + 8192 + wave * 1024), 16, 0, 0); }
}

DI f32x16 co_qk(LAS unsigned char* st, const bf16x8 (&qf)[8], int ka) {
    f32x16 S0, S1;
#pragma unroll
    for (int i = 0; i < 16; ++i) { S0[i] = 0.f; S1[i] = 0.f; }
#pragma unroll
    for (int ks = 0; ks < 8; ks += 2) {
        const bf16x8 a0 = *(const LAS bf16x8*)(st + (ka ^ (32 * ks)));
        const bf16x8 a1 = *(const LAS bf16x8*)(st + (ka ^ (32 * ks + 32)));
        S0 = MFMA32(a0, qf[ks], S0); S1 = MFMA32(a1, qf[ks + 1], S1); }
#pragma unroll
    for (int i = 0; i < 16; ++i) S0[i] += S1[i];
    return S0;
}

template <int MODE, bool FULL>
DI void co_tile(LAS unsigned char* st, int key_base, const bf16x8 (&qf)[8], AttnState& as, int tq, bool rowsel, int ka_in, int vb_in, int hh) {
    const int ka = opaque_i(ka_in), vb = opaque_i(vb_in);
    f32x16 S = co_qk(st, qf, ka);
    if (!FULL) {
        const int base = key_base + 4 * hh;
        const int hi = (MODE == 0) ? (((tq - 31) >> 4) - base) : (tq - base);
        const int lo = hi - 512;
#pragma unroll
        for (int i = 0; i < 16; ++i) { const int c = (i & 3) + 8 * (i >> 2); bool ok = (c <= hi); if (MODE == 2) ok = ok && (c > lo); S[i] = ok ? S[i] : -1e30f; }
    }
    if (MODE == 1) {
#pragma unroll
        for (int i = 0; i < 16; ++i) S[i] = rowsel ? S[i] : -1e30f;
    }
    float mx = S[0];
#pragma unroll
    for (int i = 1; i < 16; ++i) mx = fmaxf(mx, S[i]);
    mx = xh_max(mx);
    const float mxs = mx * SM_SCALE; const bool need = mxs > as.m + 8.f;
    const float mnew = need ? mxs : as.m, muse = -fmaxf(mnew, -1e20f); float ps = 0.f;
#pragma unroll
    for (int i = 0; i < 16; ++i) { const float p = __builtin_amdgcn_exp2f(__builtin_fmaf(S[i], SM_SCALE, muse)); S[i] = p; ps += p; }
    ps = xh_sum(ps);
    if (__builtin_amdgcn_ballot_w64(need) != 0ull) {
        const float alpha = __builtin_amdgcn_exp2f(as.m - mnew);
        as.l *= alpha;
#pragma unroll
        for (int dt = 0; dt < 4; ++dt)
#pragma unroll
            for (int i = 0; i < 16; ++i) as.acc[dt][i] *= alpha;
    }
    as.l += ps; as.m = mnew;
    const bf16x8 p0 = pack8(S, 0), p1 = pack8(S, 1);
#pragma unroll
    for (int dt = 0; dt < 4; ++dt) {
        LAS unsigned char* vp = st + 2048 * dt;
        const bf16x8 a0 = cat44(*(const LAS s16x4*)(vp + (vb ^ 0)), *(const LAS s16x4*)(vp + (vb ^ 16))), a1 = cat44(*(const LAS s16x4*)(vp + (vb ^ 32)), *(const LAS s16x4*)(vp + (vb ^ 48)));
        as.acc[dt] = MFMA32(a0, p0, as.acc[dt]); as.acc[dt] = MFMA32(a1, p1, as.acc[dt]);
    }
}

DI f32x16 co_qk1(LAS unsigned char* st, const bf16x8 (&qf)[8], int ka_in) {
    const int ka = ka_in;
    f32x16 S;
#pragma unroll
    for (int i = 0; i < 16; ++i) S[i] = 0.f;
    __builtin_amdgcn_s_setprio(1);
#pragma unroll
    for (int ks = 0; ks < 8; ++ks) { const bf16x8 a = *(const LAS bf16x8*)(st + (ka ^ (32 * ks))); S = MFMA32(a, qf[ks], S); }
    __builtin_amdgcn_s_setprio(0);
    return S;
}
template <int MODE>
DI void co_finish(f32x16 S, LAS unsigned char* st, int key_base, AttnState& as, int tq, bool rowsel, int vb_in, int hh) {
    const int vb = vb_in;
    {
        const int base = key_base + 4 * hh;
        const int hi = (MODE == 0) ? (((tq - 31) >> 4) - base) : (tq - base);
        const int lo = hi - 512;
#pragma unroll
        for (int i = 0; i < 16; ++i) { const int c = (i & 3) + 8 * (i >> 2); bool ok = (c <= hi); if (MODE == 2) ok = ok && (c > lo); if (MODE == 1) ok = ok && rowsel; S[i] = ok ? S[i] : -1e30f; }
    }
    float mx = S[0];
#pragma unroll
    for (int i = 1; i < 16; ++i) mx = fmaxf(mx, S[i]);
    mx = xh_max(mx);
    const float mxs = mx * SM_SCALE; const bool need = mxs > as.m + 8.f;
    const float mnew = need ? mxs : as.m, muse = -fmaxf(mnew, -1e20f); float ps = 0.f;
#pragma unroll
    for (int i = 0; i < 16; ++i) { const float p = __builtin_amdgcn_exp2f(__builtin_fmaf(S[i], SM_SCALE, muse)); S[i] = p; ps += p; }
    ps = xh_sum(ps);
    if (__builtin_amdgcn_ballot_w64(need) != 0ull) {
        const float alpha = __builtin_amdgcn_exp2f(as.m - mnew);
        as.l *= alpha;
#pragma unroll
        for (int dt = 0; dt < 4; ++dt)
#pragma unroll
            for (int i = 0; i < 16; ++i) as.acc[dt][i] *= alpha;
    }
    as.l += ps; as.m = mnew;
    const bf16x8 p0 = pack8(S, 0), p1 = pack8(S, 1);
    __builtin_amdgcn_s_setprio(1);
#pragma unroll
    for (int dt = 0; dt < 4; ++dt) {
        LAS unsigned char* vp = st + 2048 * dt;
        const bf16x8 a0 = cat44(*(const LAS s16x4*)(vp + (vb ^ 0)), *(const LAS s16x4*)(vp + (vb ^ 16))), a1 = cat44(*(const LAS s16x4*)(vp + (vb ^ 32)), *(const LAS s16x4*)(vp + (vb ^ 48)));
        as.acc[dt] = MFMA32(a0, p0, as.acc[dt]); as.acc[dt] = MFMA32(a1, p1, as.acc[dt]);
    }
    __builtin_amdgcn_s_setprio(0);
}
#define CO_STEP2(list, n, i) do { \
    if ((n) - 1 - (i) >= 1) asm volatile("s_waitcnt vmcnt(2)" ::: "memory"); else asm volatile("s_waitcnt vmcnt(0)" ::: "memory"); \
    asm volatile("s_waitcnt lgkmcnt(0)" ::: "memory"); __builtin_amdgcn_s_barrier(); asm volatile("" ::: "memory"); \
    if ((i) + 2 < (n)) co_issue(P, ring, ((i) + 2) & 3, (list)[(i) + 2], b, g, wave, lane); } while (0)
#define CO_PIPE(MODE, REL, KB, RS) do { const bool rel_ = (REL); LAS unsigned char* sp_ = ring + (i & 3) * 16384; f32x16 Sn_; \
    if (rel_) Sn_ = co_qk1(sp_, qf, ka); \
    if (pend) co_finish<MODE>(Sp, pst, pkb, st, tq, prs, vb, hh); \
    pend = rel_; if (rel_) { Sp = Sn_; pst = sp_; pkb = (KB); prs = (RS); } } while (0)
#define CO_DRAIN(MODE) do { if (pend) { co_finish<MODE>(Sp, pst, pkb, st, tq, prs, vb, hh); pend = false; } } while (0)

#define CO_STEP(list, n, i) do { const int rem_ = (n) - 1 - (i); \
    if (rem_ >= 2) asm volatile("s_waitcnt vmcnt(4)" ::: "memory"); else if (rem_ == 1) asm volatile("s_waitcnt vmcnt(2)" ::: "memory"); else asm volatile("s_waitcnt vmcnt(0)" ::: "memory"); \
    asm volatile("s_waitcnt lgkmcnt(0)" ::: "memory"); __builtin_amdgcn_s_barrier(); asm volatile("" ::: "memory"); \
    if ((i) + 3 < (n)) co_issue(P, ring, ((i) + 3) & 3, (list)[(i) + 3], b, g, wave, lane); } while (0)
#define CO_BAR() do { asm volatile("s_waitcnt lgkmcnt(0)" ::: "memory"); __builtin_amdgcn_s_barrier(); asm volatile("" ::: "memory"); } while (0)

DI void nsa_block_item(const Params& P, unsigned char* smem_g, int b, int g, int tb, int tid_in) {
    LAS unsigned char* sm = (LAS unsigned char*)smem_g;
    const int tid = opaque_i(tid_in), lane = tid & 63, wave = __builtin_amdgcn_readfirstlane(tid >> 6);
    const int l32 = lane & 31, hh = lane >> 5; const int tki = l32 >> 3, head = g * 8 + (l32 & 7);
    const int t0b = tb * 32, t0 = t0b + 4 * wave, tq = t0 + tki;
    const unsigned tok = (unsigned)(b * TT + tq); const unsigned poff = tok * (unsigned)LDP; const unsigned ooff = tok * 4096u + 2048u + (unsigned)head * 128u;
    const int ka = l32 * 256 + 16 * (hh ^ (l32 & 15)), vb = 8192 + l32 * 64 + 8 * hh + 16 * ((l32 >> 2) & 3);
    LAS unsigned char* ring = sm + CO_RING; LAS u32x2* totw = (LAS u32x2*)(sm + CO_TOT + wave * 8192);
    LAS float* psum = (LAS float*)(sm + CO_SCR + wave * 2560); LAS unsigned* vals = (LAS unsigned*)(sm + CO_SCR + wave * 2560 + 2048);
    LAS unsigned* list1 = (LAS unsigned*)(sm + CO_LIST); LAS unsigned* list2 = list1 + 32; LAS unsigned* uw = (LAS unsigned*)(sm + CO_UW);
    bf16x8 qf[8];
    {
        float qv[64]; float s = 0.f;
#pragma unroll
        for (int ks = 0; ks < 8; ++ks) { const u32x4 a = *(const u32x4*)(P_proj + (poff + C_Q + head * 128 + 16 * ks + 8 * hh)); const unsigned uw4[4] = {a.x, a.y, a.z, a.w};
#pragma unroll
            for (int j = 0; j < 4; ++j) { const float v0 = lo16(uw4[j]), v1 = hi16(uw4[j]); qv[8 * ks + 2 * j] = v0; qv[8 * ks + 2 * j + 1] = v1; s += v0 * v0 + v1 * v1; } }
        s += __shfl_xor(s, 32);
        const float rstd = 1.f / sqrtf(s * (1.f / 128.f) + EPSF);
#pragma unroll
        for (int ks = 0; ks < 8; ++ks) { const f32x4 w0 = *(const f32x4*)(P.q_norm_w + 16 * ks + 8 * hh), w1 = *(const f32x4*)(P.q_norm_w + 16 * ks + 8 * hh + 4);
            u32x4 o; o.x = pk2(qv[8 * ks + 0] * rstd * w0[0], qv[8 * ks + 1] * rstd * w0[1]); o.y = pk2(qv[8 * ks + 2] * rstd * w0[2], qv[8 * ks + 3] * rstd * w0[3]);
            o.z = pk2(qv[8 * ks + 4] * rstd * w1[0], qv[8 * ks + 5] * rstd * w1[1]); o.w = pk2(qv[8 * ks + 6] * rstd * w1[2], qv[8 * ks + 7] * rstd * w1[3]);
            qf[ks] = __builtin_bit_cast(bf16x8, o); }
    }
    const float g0 = sigmoidf_(bf2f(P_proj[poff + C_GATE + head * 3 + 0])), g1 = sigmoidf_(bf2f(P_proj[poff + C_GATE + head * 3 + 1])), g2 = sigmoidf_(bf2f(P_proj[poff + C_GATE + head * 3 + 2]));
    const int nA = (((t0b >> 4) + 1) + 31) >> 5;
    int lo = t0b - 511; if (lo < 0) lo = 0; lo &= ~31;
    const int nD = ((t0b - lo) >> 5) + 1, n1 = 2 * nA + nD;
    asm volatile("s_waitcnt vmcnt(0)" ::: "memory");
    CO_BAR();
    if (tid < n1) { const unsigned d = tid < nA ? (unsigned)(tid * 32) : (tid < 2 * nA ? ((1u << 16) | (unsigned)((tid - nA) * 32)) : ((2u << 16) | (unsigned)(lo + (tid - 2 * nA) * 32))); list1[tid] = d; }
    CO_BAR();
    AttnState st;
    bool pend = false, prs = false; f32x16 Sp; int pkb = 0; LAS unsigned char* pst = ring;
#pragma unroll
    for (int i2 = 0; i2 < 16; ++i2) Sp[i2] = 0.f;
#pragma unroll
    for (int s = 0; s < 2; ++s) if (s < n1) co_issue(P, ring, s, list1[s], b, g, wave, lane);
    int i = 0;
    attn_reset(st);
    for (; i < nA; ++i) { CO_STEP2(list1, n1, i); const int kb_ = 32 * i; CO_PIPE(0, 16 * kb_ + 31 <= t0 + 3, kb_, true); }
    CO_DRAIN(0);
    {
        const float inv = st.l > 0.f ? g0 / st.l : 0.f;
#pragma unroll
        for (int dt = 0; dt < 4; ++dt)
#pragma unroll
            for (int ig = 0; ig < 4; ++ig) { u32x2 w; w.x = pk2(st.acc[dt][4 * ig] * inv, st.acc[dt][4 * ig + 1] * inv); w.y = pk2(st.acc[dt][4 * ig + 2] * inv, st.acc[dt][4 * ig + 3] * inv); totw[(dt * 4 + ig) * 64 + lane] = w; }
    }
    {
        const float invl = st.l > 0.f ? 1.f / st.l : 0.f; const float mfin = st.m;
        for (int k = lane; k < 512; k += 64) psum[k] = 0.f;
        for (; i < 2 * nA; ++i) {
            CO_STEP2(list1, n1, i); const int kb_ = 32 * (i - nA);
            if (16 * kb_ + 31 <= t0 + 3) {
                f32x16 S = co_qk(ring + (i & 3) * 16384, qf, ka);
#pragma unroll
                for (int r = 0; r < 16; ++r) { const int cidx = kb_ + crow(r, hh); const bool ok = (16 * cidx + 31 <= tq);
                    float p = ok ? __builtin_amdgcn_exp2f(S[r] * SM_SCALE - mfin) * invl : 0.f;
                    p = sum8_dpp(p);
                    if ((lane & 7) == 0) psum[tki * 128 + cidx] = p; }
            }
        }
    }
    LDS_FENCE();
    unsigned selm[4];
#pragma unroll
    for (int tt = 0; tt < 2; ++tt) {
        const int tkn = 2 * tt + hh, j = l32; const int tqq = t0 + tkn, cur = tqq >> 6;
        float imp = 0.f;
#pragma unroll
        for (int c = -1; c < 4; ++c) { const int ci = 4 * j + c; if (ci >= 0) imp += psum[tkn * 128 + ci]; }
        const bool forced = (j == cur) || (j == 0), validb = (j <= cur);
        const unsigned key = forced ? 0x7f000000u : (validb ? (__float_as_uint(fmaxf(imp, 0.f)) + 1u) : 0u);
        vals[tkn * 32 + j] = key;
        LDS_FENCE();
        const unsigned long long kk = ((unsigned long long)key << 5) | (unsigned)(31 - j);
        int rank = 0;
#pragma unroll 4
        for (int jj = 0; jj < 32; ++jj) { const unsigned long long ko = ((unsigned long long)vals[tkn * 32 + jj] << 5) | (unsigned)(31 - jj); rank += (ko > kk) ? 1 : 0; }
        const unsigned long long bal = __ballot(rank < 8);
        selm[2 * tt] = (unsigned)bal; selm[2 * tt + 1] = (unsigned)(bal >> 32);
    }
    const unsigned mysel = tki == 0 ? selm[0] : (tki == 1 ? selm[1] : (tki == 2 ? selm[2] : selm[3]));
    const int curw = t0 >> 6; const unsigned validw = (curw >= 31) ? 0xffffffffu : ((2u << curw) - 1u);
    const unsigned Uw = (unsigned)__builtin_amdgcn_readfirstlane((int)((selm[0] | selm[1] | selm[2] | selm[3]) & validw));
    if (lane == 0) uw[wave] = Uw;
    attn_reset(st);
    for (; i < n1; ++i) { CO_STEP2(list1, n1, i); const int kb_ = lo + 32 * (i - 2 * nA); CO_PIPE(2, kb_ + 31 >= t0 - 511 && kb_ <= t0 + 3, kb_, true); }
    CO_DRAIN(2);
    {
        const float inv = st.l > 0.f ? g2 / st.l : 0.f;
#pragma unroll
        for (int dt = 0; dt < 4; ++dt)
#pragma unroll
            for (int ig = 0; ig < 4; ++ig) { const u32x2 pv = totw[(dt * 4 + ig) * 64 + lane];
                u32x2 w; w.x = pk2(lo16(pv.x) + st.acc[dt][4 * ig] * inv, hi16(pv.x) + st.acc[dt][4 * ig + 1] * inv); w.y = pk2(lo16(pv.y) + st.acc[dt][4 * ig + 2] * inv, hi16(pv.y) + st.acc[dt][4 * ig + 3] * inv);
                totw[(dt * 4 + ig) * 64 + lane] = w; }
    }
    CO_BAR();
    unsigned Ub = 0u;
#pragma unroll
    for (int w = 0; w < 8; ++w) Ub |= uw[w];
    Ub = (unsigned)__builtin_amdgcn_readfirstlane((int)Ub);
    const int curb = t0b >> 6; const bool last_single = ((t0b & 32) == 0);
    const int n2 = 2 * __builtin_popcount(Ub) - (last_single ? 1 : 0);
    if (tid < 32 && ((Ub >> tid) & 1u)) { const int pos = 2 * __builtin_popcount(Ub & ((1u << tid) - 1u)); list2[pos] = (3u << 16) | (unsigned)(64 * tid); if (!(tid == curb && last_single)) list2[pos + 1] = (3u << 16) | (unsigned)(64 * tid + 32); }
    CO_BAR();
#pragma unroll
    for (int s = 0; s < 2; ++s) if (s < n2) co_issue(P, ring, s, list2[s], b, g, wave, lane);
    attn_reset(st);
    for (i = 0; i < n2; ++i) {
        CO_STEP2(list2, n2, i); const int kb_ = (int)(list2[i] & 0xffffu); const int j = kb_ >> 6;
        CO_PIPE(1, ((Uw >> j) & 1u) && kb_ <= t0 + 3, kb_, (bool)((mysel >> j) & 1u));
    }
    CO_DRAIN(1);
    {
        const int lane2 = opaque_i(lane); const int hh = lane2 >> 5, head = g * 8 + (lane2 & 7); const unsigned tok = (unsigned)(b * TT + t0 + ((lane2 & 31) >> 3));
        const unsigned poff = tok * (unsigned)LDP, ooff = tok * 4096u + 2048u + (unsigned)head * 128u;
        const float inv = st.l > 0.f ? g1 / st.l : 0.f;
#pragma unroll
        for (int dt = 0; dt < 4; ++dt)
#pragma unroll
            for (int ig = 0; ig < 4; ++ig) { const int d0 = 32 * dt + 8 * ig + 4 * hh;
                const u32x2 zz = *(const u32x2*)(P_proj + (poff + C_ZNSA + head * 128 + d0)); const u32x2 pv = totw[(dt * 4 + ig) * 64 + lane];
                const float o0 = st.acc[dt][4 * ig + 0] * inv + lo16(pv.x), o1 = st.acc[dt][4 * ig + 1] * inv + hi16(pv.x), o2 = st.acc[dt][4 * ig + 2] * inv + lo16(pv.y), o3 = st.acc[dt][4 * ig + 3] * inv + hi16(pv.y);
                u32x2 w; w.x = pk2(o0 * siluf_(lo16(zz.x)), o1 * siluf_(hi16(zz.x))); w.y = pk2(o2 * siluf_(lo16(zz.y)), o3 * siluf_(hi16(zz.y)));
                *(u32x2*)(P_onsa + (ooff + d0)) = w; }
    }
}

#ifndef NSA_COOP
#define NSA_COOP 1
#endif
DI void phase_nsa(const Params& P, unsigned char* smem) {
    const int tid = opaque_tid(), lane = tid & 63, wave = __builtin_amdgcn_readfirstlane(tid >> 6);
    LAS unsigned char* wl = (LAS unsigned char*)smem + wave * NSA_WAVE_LDS;
    for (int tk = blockIdx.x * 512 + tid; tk < NTOK; tk += gridDim.x * 512) {
        const f32x4* pp = (const f32x4*)(P_part + (size_t)tk * 64); float s = 0.f;
#pragma unroll
        for (int j = 0; j < 16; ++j) { const f32x4 v = pp[j]; s += (v[0] + v[1]) + (v[2] + v[3]); }
        P_rstd[tk] = 1.f / sqrtf(s * (1.f / 2048.f) + EPSF);
    }
#if NSA_COOP
    __syncthreads();
    for (int id = blockIdx.x; id < 2048; id += gridDim.x) {
        const int bg = id & 31; int tb = id >> 5; if ((tb >> 3) & 1) tb = (tb & ~7) | (7 - (tb & 7));
        nsa_block_item(P, smem, bg >> 1, bg & 1, tb, tid);
    }
    (void)wl; (void)lane;
#else
    const int nw = gridDim.x * 8;
    for (int id = blockIdx.x * 8 + wave; id < 16384; id += nw) {
        const int bg = id & 31, t4 = id >> 5;
        nsa_item(P, wl, bg >> 1, bg & 1, t4 * 4, lane);
    }
#endif
}

#define XB_TMO      128
#define XB_XCNT(j)  (256  + 64 * (j))
#define XB_XSUB(j)  (1280 + 64 * (j))
#define XB_XGEN(j)  (2304 + 64 * (j))
#define XB_TOP      3328
#define XB_TOPGEN   3392
#define XCD_BAR_WORDS 3456
#define XB_SPIN_CAP (1u << 18)
DI unsigned xb_ld(unsigned* p)              { return __hip_atomic_load(p, __ATOMIC_RELAXED, __HIP_MEMORY_SCOPE_AGENT); }
DI unsigned xb_add(unsigned* p, unsigned v) { return __hip_atomic_fetch_add(p, v, __ATOMIC_RELAXED, __HIP_MEMORY_SCOPE_AGENT); }
DI unsigned xb_xcc_id() { return (unsigned)__builtin_amdgcn_s_getreg((3 << 11) | 20) & 0xFu; }
#define XB_SPIN(cond, bar) do { unsigned _sp = 0; while (cond) { __builtin_amdgcn_s_sleep(1); \
    if ((++_sp & 255u) == 0u) { if (xb_ld(&(bar)[XB_TMO])) break; if (_sp > XB_SPIN_CAP) { atomicAdd(&(bar)[XB_TMO], 1u); break; } } } } while (0)
struct XcdBarrier { unsigned* bar; unsigned x; volatile LAS unsigned* st; };
DI XcdBarrier xcd_barrier_post(unsigned* bar, volatile LAS unsigned* st) {
    XcdBarrier b; b.bar = bar; b.x = xb_xcc_id(); b.st = st;
    if (threadIdx.x == 0) (void)xb_add(&bar[XB_XCNT(b.x)], 1u);
    return b;
}
DI void xcd_barrier_complete(unsigned* bar, unsigned x, unsigned& nloc, unsigned& nx) {
    const unsigned G = gridDim.x * gridDim.y * gridDim.z;
    unsigned sum, cnt, mine, sp = 0u;
    for (;;) {
        sum = 0u; cnt = 0u; mine = 0u;
#pragma unroll
        for (unsigned j = 0; j < 16; ++j) { const unsigned c = xb_ld(&bar[XB_XCNT(j)]); sum += c; cnt += (c > 0u) ? 1u : 0u; mine = (j == x) ? c : mine; }
        if (sum == G) break;
        __builtin_amdgcn_s_sleep(1);
        if ((++sp & 255u) == 0u) { if (xb_ld(&bar[XB_TMO])) break; if (sp > XB_SPIN_CAP) { atomicAdd(&bar[XB_TMO], 1u); break; } }
    }
    nloc = mine > 0u ? mine : 1u; nx = cnt > 0u ? cnt : 1u;
}
DI void xcd_barrier(const XcdBarrier& b) {
    asm volatile("s_waitcnt vmcnt(0)" ::: "memory");
    __syncthreads();
    if (threadIdx.x == 0) {
        unsigned* bar = b.bar;
        __builtin_amdgcn_s_waitcnt(0);
        unsigned nloc = b.st[0], nx = b.st[1];
        if (nloc == 0u) { xcd_barrier_complete(bar, b.x, nloc, nx); b.st[0] = nloc; b.st[1] = nx; }
        const unsigned old = xb_add(&bar[XB_XSUB(b.x)], 1u);
        const unsigned gen = old / nloc;
        if (old + 1u == (gen + 1u) * nloc) {
            __builtin_amdgcn_fence(__ATOMIC_RELEASE, "agent");
            asm volatile("s_waitcnt vmcnt(0)" ::: "memory");
            const unsigned og = xb_add(&bar[XB_TOP], 1u);
            const unsigned tg = og / nx;
            if (og + 1u == (tg + 1u) * nx) xb_add(&bar[XB_TOPGEN], 1u);
            else XB_SPIN(xb_ld(&bar[XB_TOPGEN]) == tg, bar);
            __builtin_amdgcn_fence(__ATOMIC_ACQUIRE, "agent");
            xb_add(&bar[XB_XGEN(b.x)], 1u);
            asm volatile("s_waitcnt vmcnt(0)" ::: "memory");
        } else {
            XB_SPIN(xb_ld(&bar[XB_XGEN(b.x)]) == gen, bar);
            __builtin_amdgcn_fence(__ATOMIC_ACQUIRE, "agent");
            asm volatile("s_waitcnt vmcnt(0)" ::: "memory");
        }
    }
    __syncthreads();
}

template <int PH>
DI void run_phase(const Params& P, unsigned char* smem) {
    pg8::StaticOrder S;
    if constexpr (PH == 0) phase_prep(P, smem);
    else if constexpr (PH == 1) { pg8::Gemm gm{P_h, P_winT, NTOK, LDP, DM, DM, DM}; S.init(NTOK, LDP, gridDim.x, blockIdx.x); pg8::EpiProj E{P_proj, LDP}; pg8::gemm_phase((LAS unsigned char*)smem, gm, S, E); }
    else if constexpr (PH == 2) phase_mix(P, smem);
    else if constexpr (PH == 3) phase_nsa(P, smem);
    else if constexpr (PH == 4) {
        S.init(NTOK, DM, gridDim.x, blockIdx.x);
        pg8::Gemm gm{P_yg, P_wossdT, NTOK, DM, 4096, 4096, 4096}; pg8::EpiMergeF E{P_proj, P_rstd}; pg8::gemm_phase((LAS unsigned char*)smem, gm, S, E);
    }
    else if constexpr (PH == 6) phase_bcconv(P);
    else if constexpr (PH == 5) { pg8::Gemm gm{P_proj, P_woT, NTOK, DM, DM, LDP, DM}; S.init(NTOK, DM, gridDim.x, blockIdx.x); pg8::EpiOut E{P.out, P.x}; pg8::gemm_phase((LAS unsigned char*)smem, gm, S, E); }
}

template <int LO, int HI>
__global__ void __launch_bounds__(512) fwd_kernel(Params P) {
    extern __shared__ __attribute__((aligned(16))) unsigned char smem[];
    if constexpr (HI - LO > 1) {
        cg::grid_group grid = cg::this_grid();
        if (P.ws == nullptr) grid.sync();
        volatile LAS unsigned* xst = (volatile LAS unsigned*)((LAS unsigned char*)smem + (LDS_BYTES - 16));
        if (threadIdx.x == 0) { xst[0] = 0u; xst[1] = 0u; }
        __syncthreads();
        const XcdBarrier xb = xcd_barrier_post((unsigned*)(P.ws + WS_BAR), xst);
        run_phase<0>(P, smem); xcd_barrier(xb);
        run_phase<1>(P, smem); xcd_barrier(xb);
        run_phase<6>(P, smem); xcd_barrier(xb);
        run_phase<2>(P, smem); xcd_barrier(xb);
        run_phase<3>(P, smem); xcd_barrier(xb);
        run_phase<4>(P, smem); xcd_barrier(xb);
        run_phase<5>(P, smem);
    } else {
        run_phase<LO>(P, smem);
    }
}

template <class K> static int setup_kernel(K kern) {
    if (hipFuncSetAttribute((const void*)kern, hipFuncAttributeMaxDynamicSharedMemorySize, LDS_BYTES) != hipSuccess) { fprintf(stderr, "kernel_launch: hipFuncSetAttribute failed\n"); return -1; }
    return 0;
}

extern "C" void kernel_launch(void* const* d_in, const int* in_sizes, int n_in, void* d_out, int out_size, void* d_ws, size_t ws_size, hipStream_t stream) {
    static int grid = 0;
    if (grid == 0) {
        if (n_in != 24 || in_sizes[0] != NTOK * DM || out_size != NTOK * DM || ws_size < WS_END) {
            fprintf(stderr, "kernel_launch: unexpected shapes / workspace (n_in %d, ws %zu, need %zu); nothing launched\n", n_in, ws_size, (size_t)WS_END); grid = -1; return; }
        int dev = 0, cus = 0, per_cu = 0;
        (void)hipGetDevice(&dev); (void)hipDeviceGetAttribute(&cus, hipDeviceAttributeMultiprocessorCount, dev);
#if ONE_LAUNCH
        if (setup_kernel(fwd_kernel<0, 6>)) { grid = -1; return; }
        (void)hipOccupancyMaxActiveBlocksPerMultiprocessor(&per_cu, (const void*)fwd_kernel<0, 6>, 512, LDS_BYTES);
        if (per_cu < 1) fprintf(stderr, "kernel_launch: occupancy query says %d blocks per CU\n", per_cu);
#else
        if (setup_kernel(fwd_kernel<0, 1>) || setup_kernel(fwd_kernel<1, 2>) || setup_kernel(fwd_kernel<2, 3>) || setup_kernel(fwd_kernel<3, 4>) || setup_kernel(fwd_kernel<4, 5>) || setup_kernel(fwd_kernel<5, 6>)) { grid = -1; return; }
#endif
        (void)hipGetLastError();
        grid = cus * 1;
    }
    if (grid < 0) return;
    Params p{};
    const float** fp = (const float**)&p;
    for (int i = 0; i < 24; ++i) fp[i] = (const float*)d_in[i];
    p.out = (float*)d_out; p.ws = (unsigned char*)d_ws;
#if ONE_LAUNCH
    if (hipMemsetAsync((unsigned char*)d_ws + WS_BAR, 0, XCD_BAR_WORDS * 4, stream) != hipSuccess) { fprintf(stderr, "kernel_launch: hipMemsetAsync failed\n"); return; }
    void* args[] = {&p};
    hipError_t e = hipLaunchCooperativeKernel((const void*)fwd_kernel<0, 6>, dim3(grid), dim3(512), args, LDS_BYTES, stream);
    if (e != hipSuccess) fprintf(stderr, "cooperative launch failed: %s (grid %d)\n", hipGetErrorString(e), grid);
#else
    hipLaunchKernelGGL((fwd_kernel<0, 1>), dim3(grid), dim3(512), LDS_BYTES, stream, p);
    hipLaunchKernelGGL((fwd_kernel<1, 2>), dim3(grid), dim3(512), LDS_BYTES, stream, p);
    hipLaunchKernelGGL((fwd_kernel<2, 3>), dim3(grid), dim3(512), LDS_BYTES, stream, p);
    hipLaunchKernelGGL((fwd_kernel<3, 4>), dim3(grid), dim3(512), LDS_BYTES, stream, p);
    hipLaunchKernelGGL((fwd_kernel<4, 5>), dim3(grid), dim3(512), LDS_BYTES, stream, p);
    hipLaunchKernelGGL((fwd_kernel<5, 6>), dim3(grid), dim3(512), LDS_BYTES, stream, p);
#endif
}
```
